# Optimizing an MI355X kernel written in HIP

```python
import math
import jax, jax.numpy as jnp
from jax import lax
import numpy as np

D_MODEL = 1024
BATCH = 4
SEQ = 8192
DEPTH = 2

GRID_W = 64
CTX_LEN = 256
HEAD_DIM = 64
N_HEADS = D_MODEL // HEAD_DIM
NA_HEADS = N_HEADS // 2
GQA_Q_HEADS = N_HEADS - NA_HEADS
GQA_KV_HEADS = GQA_Q_HEADS // 4
WIN_R = 8
WIN_C = 16
DIFF_HEADS = N_HEADS // 2
DIFF_V_DIM = 2 * HEAD_DIM
D_FF = -(-8 * D_MODEL // (3 * 256)) * 256
Q_BLOCK = 128
ROPE_THETA = 10000.0
EPS = 1e-6
N_MOD = 6

NA_WIDTH = NA_HEADS * HEAD_DIM
GQA_Q_WIDTH = GQA_Q_HEADS * HEAD_DIM
GQA_KV_WIDTH = GQA_KV_HEADS * HEAD_DIM
PAR_IN = 3 * NA_WIDTH + GQA_Q_WIDTH + 2 * GQA_KV_WIDTH
PAR_SPLITS = (NA_WIDTH, 2 * NA_WIDTH, 3 * NA_WIDTH, 3 * NA_WIDTH + GQA_Q_WIDTH,
              3 * NA_WIDTH + GQA_Q_WIDTH + GQA_KV_WIDTH)
PAR_OUT = (NA_HEADS + GQA_Q_HEADS) * HEAD_DIM
DIFF_IN = 3 * DIFF_HEADS * 2 * HEAD_DIM
DIFF_OUT = DIFF_HEADS * DIFF_V_DIM

kernel_name = "hybrid_natten_gqa_diffattn_dit"


def rms_norm(x, gain=None):
    xf = x.astype(jnp.float32)
    y = xf * lax.rsqrt(jnp.mean(xf * xf, axis=-1, keepdims=True) + EPS)
    if gain is not None:
        y = y * gain.astype(jnp.float32)
    return y.astype(x.dtype)


def ada_params(cond, w, b):
    m = jax.nn.silu(cond) @ w + b
    return jnp.split(m[..., None, :], N_MOD, axis=-1)


def modulate(h, shift, scale):
    return h * (1.0 + scale) + shift


def axial_angles(n_tokens):
    t = jnp.arange(n_tokens)
    row = (t // GRID_W).astype(jnp.float32)
    col = (t % GRID_W).astype(jnp.float32)
    n_freq = HEAD_DIM // 4
    inv = ROPE_THETA ** (-jnp.arange(n_freq, dtype=jnp.float32) / n_freq)
    ang = jnp.concatenate([row[:, None] * inv, col[:, None] * inv], axis=-1)
    return jnp.cos(ang), jnp.sin(ang)


def apply_rope(x, cos, sin):
    xf = x.astype(jnp.float32).reshape(x.shape[:-1] + (HEAD_DIM // 2, 2))
    x1, x2 = xf[..., 0], xf[..., 1]
    out = jnp.stack([x1 * cos - x2 * sin, x1 * sin + x2 * cos], axis=-1)
    return out.reshape(x.shape).astype(x.dtype)


def to_heads(t, n_heads):
    b, l, _ = t.shape
    return t.reshape(b, l, n_heads, -1).transpose(0, 2, 1, 3)


def merge_heads(o):
    b, h, l, d = o.shape
    return o.transpose(0, 2, 1, 3).reshape(b, l, h * d)


def grouped_attention(q, k, v):
    b, hq, lq, dh = q.shape
    hkv = k.shape[1]
    qg = q.reshape(b, hkv, hq // hkv, lq, dh)
    s = jnp.einsum('bhgqd,bhkd->bhgqk', qg, k).astype(jnp.float32) * (dh ** -0.5)
    p = jax.nn.softmax(s, axis=-1).astype(v.dtype)
    return jnp.einsum('bhgqk,bhkd->bhgqd', p, v).reshape(b, hq, lq, v.shape[-1])


def sweep_queries(attend, *qs):
    b, h, l, _ = qs[0].shape
    nb = l // Q_BLOCK
    blocks = tuple(q.reshape(b, h, nb, Q_BLOCK, q.shape[-1]).transpose(2, 0, 1, 3, 4) for q in qs)
    out = lax.map(lambda blk: attend(*blk), blocks)
    return out.transpose(1, 2, 0, 3, 4).reshape(b, h, l, out.shape[-1])


def neighbourhood_attention(q, k, v, kc, vc, rpb):
    b, h, l, dh = q.shape
    rows = l // GRID_W
    kr = min(WIN_R, rows)
    scale = dh ** -0.5
    qg = q.reshape(b, h, rows, GRID_W, dh)
    kg = k.reshape(b, h, rows, GRID_W, dh)
    vg = v.reshape(b, h, rows, GRID_W, dh)
    cols = jnp.arange(GRID_W)
    col_start = jnp.clip(cols - WIN_C // 2, 0, GRID_W - WIN_C)
    col_idx = col_start[:, None] + jnp.arange(WIN_C)[None, :]
    col_bias = rpb[:, :, col_idx - cols[:, None] + (WIN_C - 1)]
    n_win = kr * WIN_C

    def row_block(r):
        rs = jnp.clip(r - kr // 2, 0, rows - kr)
        q_r = lax.dynamic_index_in_dim(qg, r, axis=2, keepdims=False)
        k_rows = lax.dynamic_slice_in_dim(kg, rs, kr, axis=2)
        v_rows = lax.dynamic_slice_in_dim(vg, rs, kr, axis=2)
        k_win = k_rows[:, :, :, col_idx]
        v_win = v_rows[:, :, :, col_idx]
        row_off = rs + jnp.arange(kr) - r + (WIN_R - 1)
        bias = jnp.take(col_bias, row_off, axis=1).transpose(0, 2, 1, 3)
        s_win = jnp.einsum('bhqd,bhrqjd->bhqrj', q_r, k_win).astype(jnp.float32) * scale + bias[None].astype(jnp.float32)
        s_ctx = jnp.einsum('bhqd,bhkd->bhqk', q_r, kc).astype(jnp.float32) * scale
        p = jax.nn.softmax(jnp.concatenate([s_win.reshape(b, h, GRID_W, n_win), s_ctx], axis=-1), axis=-1)
        p = p.astype(v.dtype)
        p_win = p[..., :n_win].reshape(b, h, GRID_W, kr, WIN_C)
        p_ctx = p[..., n_win:]
        return (jnp.einsum('bhqrj,bhrqjd->bhqd', p_win, v_win)
                + jnp.einsum('bhqk,bhkd->bhqd', p_ctx, vc))

    out = lax.map(row_block, jnp.arange(rows))
    return out.transpose(1, 2, 0, 3, 4).reshape(b, h, l, dh)


def parallel_mixer(h, hc, w_in, w_out, rpb, q_gain, k_gain, cos, sin, need_ctx):
    def split(p):
        nq, nk, nv, gq, gk, gv = jnp.split(p, PAR_SPLITS, axis=-1)
        return (to_heads(nq, NA_HEADS), to_heads(nk, NA_HEADS), to_heads(nv, NA_HEADS),
                rms_norm(to_heads(gq, GQA_Q_HEADS), q_gain), rms_norm(to_heads(gk, GQA_KV_HEADS), k_gain),
                to_heads(gv, GQA_KV_HEADS))
    nq, nk, nv, gq, gk, gv = split(h @ w_in)
    cnq, cnk, cnv, cgq, cgk, cgv = split(hc @ w_in)
    gq = apply_rope(gq, cos, sin)
    gk = apply_rope(gk, cos, sin)
    out_na = neighbourhood_attention(nq, nk, nv, cnk, cnv, rpb)
    k_all = jnp.concatenate([cgk, gk], axis=2)
    v_all = jnp.concatenate([cgv, gv], axis=2)
    out_gqa = sweep_queries(lambda qb: grouped_attention(qb, k_all, v_all), gq)
    y = merge_heads(jnp.concatenate([out_na, out_gqa], axis=1)) @ w_out
    yc = None
    if need_ctx:
        yc_na = grouped_attention(cnq, cnk, cnv)
        yc_g = grouped_attention(cgq, cgk, cgv)
        yc = merge_heads(jnp.concatenate([yc_na, yc_g], axis=1)) @ w_out
    return y, yc


def diff_mixer(h, hc, w_in, w_out, lq1, lk1, lq2, lk2, subln_gain, lambda_init, cos, sin, need_ctx):
    def split(p):
        b, l, _ = p.shape
        q, k, v = jnp.split(p, 3, axis=-1)
        q = q.reshape(b, l, DIFF_HEADS, 2, HEAD_DIM).transpose(0, 2, 3, 1, 4)
        k = k.reshape(b, l, DIFF_HEADS, 2, HEAD_DIM).transpose(0, 2, 3, 1, 4)
        v = v.reshape(b, l, DIFF_HEADS, DIFF_V_DIM).transpose(0, 2, 1, 3)
        return q[:, :, 0], q[:, :, 1], k[:, :, 0], k[:, :, 1], v
    lam = (jnp.exp(jnp.sum(lq1.astype(jnp.float32) * lk1.astype(jnp.float32)))
           - jnp.exp(jnp.sum(lq2.astype(jnp.float32) * lk2.astype(jnp.float32))) + lambda_init)
    scale = HEAD_DIM ** -0.5

    def attend(a1, a2, k1, k2, v):
        s1 = jnp.einsum('bhqd,bhkd->bhqk', a1, k1).astype(jnp.float32) * scale
        s2 = jnp.einsum('bhqd,bhkd->bhqk', a2, k2).astype(jnp.float32) * scale
        p = jax.nn.softmax(s1, axis=-1) - lam * jax.nn.softmax(s2, axis=-1)
        return jnp.einsum('bhqk,bhkd->bhqd', p.astype(v.dtype), v)

    def finish(o):
        return merge_heads(rms_norm(o, subln_gain) * (1.0 - lambda_init)) @ w_out

    q1, q2, k1, k2, v = split(h @ w_in)
    cq1, cq2, ck1, ck2, cv = split(hc @ w_in)
    q1, q2, k1, k2 = (apply_rope(t, cos, sin) for t in (q1, q2, k1, k2))
    k1a = jnp.concatenate([ck1, k1], axis=2)
    k2a = jnp.concatenate([ck2, k2], axis=2)
    va = jnp.concatenate([cv, v], axis=2)
    y = finish(sweep_queries(lambda a1, a2: attend(a1, a2, k1a, k2a, va), q1, q2))
    yc = None
    if need_ctx:
        yc = finish(attend(cq1, cq2, ck1, ck2, cv))
    return y, yc


def swiglu(h, w_gate, w_up, w_down):
    return (jax.nn.silu(h @ w_gate) * (h @ w_up)) @ w_down


def setup_inputs(seed: int = 0) -> dict:
    key = jax.random.key(seed)
    ks = jax.random.split(key, 22)
    n_par = (DEPTH + 1) // 2
    n_diff = DEPTH // 2
    nrm = lambda k, shape: jax.random.normal(k, shape, jnp.float32)
    w = lambda k, shape, fan_in: nrm(k, shape) * fan_in ** -0.5
    gain = lambda k, shape: 1.0 + 0.01 * nrm(k, shape)
    return {
        "x": nrm(ks[0], (BATCH, SEQ, D_MODEL)),
        "c": nrm(ks[1], (BATCH, D_MODEL)),
        "ctx": nrm(ks[2], (BATCH, CTX_LEN, D_MODEL)),
        "c_ctx": nrm(ks[3], (D_MODEL,)),
        "ada_w": 0.5 * w(ks[4], (DEPTH, D_MODEL, N_MOD * D_MODEL), D_MODEL),
        "ada_b": 0.01 * nrm(ks[5], (DEPTH, N_MOD * D_MODEL)),
        "ffn_w_gate": w(ks[6], (DEPTH, D_MODEL, D_FF), D_MODEL),
        "ffn_w_up": w(ks[7], (DEPTH, D_MODEL, D_FF), D_MODEL),
        "ffn_w_down": w(ks[8], (DEPTH, D_FF, D_MODEL), D_FF),
        "par_w_in": w(ks[9], (n_par, D_MODEL, PAR_IN), D_MODEL),
        "par_w_out": w(ks[10], (n_par, PAR_OUT, D_MODEL), PAR_OUT),
        "na_rpb": 0.02 * nrm(ks[11], (n_par, NA_HEADS, 2 * WIN_R - 1, 2 * WIN_C - 1)),
        "gqa_q_gain": gain(ks[12], (n_par, HEAD_DIM)),
        "gqa_k_gain": gain(ks[13], (n_par, HEAD_DIM)),
        "diff_w_in": w(ks[14], (n_diff, D_MODEL, DIFF_IN), D_MODEL),
        "diff_w_out": w(ks[15], (n_diff, DIFF_OUT, D_MODEL), DIFF_OUT),
        "diff_lambda_q1": 0.1 * nrm(ks[16], (n_diff, HEAD_DIM)),
        "diff_lambda_k1": 0.1 * nrm(ks[17], (n_diff, HEAD_DIM)),
        "diff_lambda_q2": 0.1 * nrm(ks[18], (n_diff, HEAD_DIM)),
        "diff_lambda_k2": 0.1 * nrm(ks[19], (n_diff, HEAD_DIM)),
        "diff_subln_gain": gain(ks[20], (n_diff, DIFF_V_DIM)),
        "final_norm_gain": gain(ks[21], (D_MODEL,)),
    }


def reference(x, c, ctx, c_ctx, ada_w, ada_b, ffn_w_gate, ffn_w_up, ffn_w_down,
              par_w_in, par_w_out, na_rpb, gqa_q_gain, gqa_k_gain,
              diff_w_in, diff_w_out, diff_lambda_q1, diff_lambda_k1, diff_lambda_q2, diff_lambda_k2,
              diff_subln_gain, final_norm_gain):
    cos, sin = axial_angles(x.shape[1])
    xc = ctx
    for l in range(DEPTH):
        need_ctx = l < DEPTH - 1
        sh1, sc1, g1, sh2, sc2, g2 = ada_params(c, ada_w[l], ada_b[l])
        csh1, csc1, cg1, csh2, csc2, cg2 = ada_params(c_ctx, ada_w[l], ada_b[l])
        h = modulate(rms_norm(x), sh1, sc1)
        hc = modulate(rms_norm(xc), csh1, csc1)
        i = l // 2
        if l % 2 == 0:
            y, yc = parallel_mixer(h, hc, par_w_in[i], par_w_out[i], na_rpb[i], gqa_q_gain[i], gqa_k_gain[i],
                                   cos, sin, need_ctx)
        else:
            lambda_init = 0.8 - 0.6 * math.exp(-0.3 * l)
            y, yc = diff_mixer(h, hc, diff_w_in[i], diff_w_out[i], diff_lambda_q1[i], diff_lambda_k1[i],
                               diff_lambda_q2[i], diff_lambda_k2[i], diff_subln_gain[i], lambda_init,
                               cos, sin, need_ctx)
        x = x + g1 * y
        x = x + g2 * swiglu(modulate(rms_norm(x), sh2, sc2), ffn_w_gate[l], ffn_w_up[l], ffn_w_down[l])
        if need_ctx:
            xc = xc + cg1 * yc
            xc = xc + cg2 * swiglu(modulate(rms_norm(xc), csh2, csc2), ffn_w_gate[l], ffn_w_up[l], ffn_w_down[l])
    return rms_norm(x, final_norm_gain)
```

```cpp
#include <hip/hip_runtime.h>
#include <hip/hip_cooperative_groups.h>
#include <cstdio>
#include <cstdint>
namespace cg = cooperative_groups;
namespace pg8 {
#define PG8_LAS __attribute__((address_space(3)))
typedef unsigned short bf16_t;
typedef short bf16x8 __attribute__((ext_vector_type(8)));
typedef float f32x4 __attribute__((ext_vector_type(4)));
typedef unsigned u32x4 __attribute__((ext_vector_type(4)));
constexpr int BM = 256, BK = 64, HALF = 128, HTB = HALF * BK * 2  , STAGE_BYTES = 8 * HTB, NXCD = 8, WGM = 8;

__host__ __device__ __forceinline__ int lds_byte(int r, int c) { const int st = (r >> 4) * 2 + (c >> 5), rr = r & 15, cc = c & 31, ob = rr * 64 + cc * 2; return st * 1024 + (ob ^ (((ob >> 9) & 1) << 5)); }
__host__ __device__ __forceinline__ void stage_rc(int b, int& R, int& C) { const int st = b / 1024, sb = b % 1024, swz = sb ^ (((sb >> 9) & 1) << 5); R = (st >> 1) * 16 + swz / 64; C = (st & 1) * 32 + (swz % 64) / 2; }
__host__ __device__ __forceinline__ int perm32(int rho) { const int n = rho >> 4, i = rho & 15; return 8 * (i >> 2) + 4 * n + (i & 3); }

struct Unit { int pm, pn, kc; };
struct Gemm { const bf16_t* A; const bf16_t* Bt; int M, N, K, ld; };

struct StaticOrder {
    static constexpr bool OPAQUE_NT = false;
    int nM, nN, nwg, G, c, skip;
    __host__ __device__ void init(int M, int N, int G_, int c_, int skip_ = 0) { skip = skip_; nM = skip ? 128 : M / BM; nN = N / BM; nwg = nM * nN; G = G_; c = c_; }
    __host__ __device__ bool next(int i, Unit& u) const {
        const long L = (long)i * G + c; if (L >= nwg) return false;
        int wgid = (int)L; { const int q = nwg / NXCD, r = nwg % NXCD, xcd = wgid % NXCD, off = wgid / NXCD; wgid = (xcd < r ? xcd * (q + 1) : r * (q + 1) + (xcd - r) * q) + off; }
        const int nig = WGM * nN, gid = wgid / nig, fm = gid * WGM, gsz = (nM - fm) < WGM ? (nM - fm) : WGM;
        u.pm = fm + ((wgid % nig) % gsz); u.pn = (wgid % nig) / gsz; u.kc = 0; if (skip) u.pm += u.pm / 32 + 1; return true;
    }
    __device__ __forceinline__ void a_ready(const Unit&) const {}
    __device__ __forceinline__ void done(const Unit&) const {}
};

struct CtxSplitOrder {
    static constexpr bool OPAQUE_NT = true;
    int nkc, G, c;
    __host__ __device__ void init(int nkc_, int G_, int c_) { nkc = nkc_; G = G_; c = c_; }
    __host__ __device__ bool next(int i, Unit& u) const { const int L = i * G + c; if (L >= 16 * nkc) return false; u.kc = L % nkc; const int t = L / nkc; u.pn = t & 3; u.pm = 33 * (t >> 2); return true; }
    __device__ __forceinline__ void a_ready(const Unit&) const {}
    __device__ __forceinline__ void done(const Unit&) const {}
};
__device__ __forceinline__ unsigned cvt_pk_bf16(float lo, float hi) { unsigned r; asm volatile("v_cvt_pk_bf16_f32 %0, %1, %2" : "=v"(r) : "v"(lo), "v"(hi)); return r; }
typedef float f32x2 __attribute__((ext_vector_type(2)));
__device__ __forceinline__ f32x2 gelu_pk(f32x2 v) {
    const f32x2 av = __builtin_elementwise_abs(v), d = av * 0.2316418882f + 1.0f;
    f32x2 t; t.x = __builtin_amdgcn_rcpf(d.x); t.y = __builtin_amdgcn_rcpf(d.y);
    f32x2 q = t * 0.5307027145f + (-0.7265760135f); q = q * t + 0.7107068705f; q = q * t + (-0.142248368f); q = q * t + 0.127414796f; q = q * t;
    const f32x2 s = (v * v) * (-0.72134752044f);
    f32x2 e; e.x = __builtin_amdgcn_exp2f(s.x); e.y = __builtin_amdgcn_exp2f(s.y);
    const f32x2 m = v * (q * e), r = v - m;
    f32x2 o; o.x = v.x < 0.f ? m.x : r.x; o.y = v.y < 0.f ? m.y : r.y; return o;
}

template <int ACT  > struct EpiBf16 {
    static constexpr bool PERM = true, AFTER_DRAIN = false; static_assert(ACT == 0 || ACT == 1, "EpiBf16: ACT is 0 (none) or 1 (gelu_pk)");
    bf16_t* O; int ldc; const float* bias; int split_cols; size_t split_stride; float scale0;
    __device__ __forceinline__ void operator()(const f32x4 (&acc)[2][2][4][2], const Unit& u, int wr, int wc, int fr, int fq) const {
        const int row0 = u.pm * BM + wr * 64 + fr; int colt = u.pn * BM; bf16_t* base = O;
        float sc = 1.f; if (split_cols) { const int t = colt / split_cols; base += (size_t)t * split_stride; colt -= t * split_cols; if (t == 0) sc = scale0; }
        const int col0 = colt + wc * 32 + 8 * fq, bcol0 = u.pn * BM + wc * 32 + 8 * fq;
        f32x4 bv[2][2];
#pragma unroll
        for (int bj = 0; bj < 2; ++bj)
#pragma unroll
            for (int n = 0; n < 2; ++n) bv[bj][n] = bias ? *(const f32x4*)(bias + bcol0 + bj * HALF + 4 * n) : (f32x4){0.f, 0.f, 0.f, 0.f};
#pragma unroll
        for (int ai = 0; ai < 2; ++ai)
#pragma unroll
            for (int m = 0; m < 4; ++m) { bf16_t* rowp = base + (size_t)(row0 + ai * HALF + m * 16) * ldc + col0;
#pragma unroll
                for (int bj = 0; bj < 2; ++bj) { f32x4 v0 = acc[ai][bj][m][0] + bv[bj][0], v1 = acc[ai][bj][m][1] + bv[bj][1];
                    if (ACT == 1) { f32x2 a = gelu_pk((f32x2){v0[0], v0[1]}), b = gelu_pk((f32x2){v0[2], v0[3]}), c = gelu_pk((f32x2){v1[0], v1[1]}), d = gelu_pk((f32x2){v1[2], v1[3]});
                        v0 = (f32x4){a.x, a.y, b.x, b.y}; v1 = (f32x4){c.x, c.y, d.x, d.y}; }
                    v0 = v0 * sc; v1 = v1 * sc; u32x4 w; w.x = cvt_pk_bf16(v0[0], v0[1]); w.y = cvt_pk_bf16(v0[2], v0[3]); w.z = cvt_pk_bf16(v1[0], v1[1]); w.w = cvt_pk_bf16(v1[2], v1[3]);
                    *(u32x4*)(rowp + bj * HALF) = w; } }
    }
};
struct EpiRes {
    static constexpr bool PERM = false, AFTER_DRAIN = false;
    const float* base_lat; long lat_bs; const float* base_ctx; long ctx_bs; float* out; const float* gate;
    __device__ __forceinline__ void operator()(const f32x4 (&acc)[2][2][4][2], const Unit& u, int wr, int wc, int fr, int fq) const {
        const int b = u.pm / 33, tt = u.pm - b * 33; const bool isctx = (tt == 0);
        const float* g = gate + (isctx ? 4 : b) * 6144;
        const float* src = isctx ? base_ctx + (size_t)b * ctx_bs : base_lat + (size_t)b * lat_bs + (size_t)(tt * 256 - 256) * 1024;
        float* dst = out + (size_t)u.pm * 256 * 1024;
        const int col0 = u.pn * BM + wc * 32 + 4 * fq;
#pragma unroll
        for (int bj = 0; bj < 2; ++bj)
#pragma unroll
            for (int n = 0; n < 2; ++n) { const f32x4 gv = *(const f32x4*)(g + col0 + bj * HALF + n * 16);
#pragma unroll
                for (int ai = 0; ai < 2; ++ai) {
#pragma unroll
                    for (int m = 0; m < 4; ++m) { const size_t off = (size_t)(ai * HALF + wr * 64 + m * 16 + fr) * 1024 + col0 + bj * HALF + n * 16;
                        const f32x4 bs = *(const f32x4*)(src + off); *(f32x4*)(dst + off) = bs + gv * acc[ai][bj][m][n]; }
                    asm volatile("" ::: "memory"); } }
    }
};
struct EpiSwiGLU {
    static constexpr bool PERM = true, AFTER_DRAIN = false;
    bf16_t* H; int ldh;
    __device__ __forceinline__ void operator()(const f32x4 (&acc)[2][2][4][2], const Unit& u, int wr, int wc, int fr, int fq) const {
        const int row0 = u.pm * BM + wr * 64 + fr, col0 = u.pn * HALF + wc * 32 + 8 * fq;
#pragma unroll
        for (int ai = 0; ai < 2; ++ai)
#pragma unroll
            for (int m = 0; m < 4; ++m) { bf16_t* rowp = H + (size_t)(row0 + ai * HALF + m * 16) * ldh + col0; float hv[8];
#pragma unroll
                for (int n = 0; n < 2; ++n)
#pragma unroll
                    for (int e = 0; e < 4; ++e) { const float g = acc[ai][0][m][n][e], up = acc[ai][1][m][n][e]; hv[n * 4 + e] = g * __builtin_amdgcn_rcpf(1.0f + __expf(-g)) * up; }
                u32x4 w; w.x = cvt_pk_bf16(hv[0], hv[1]); w.y = cvt_pk_bf16(hv[2], hv[3]); w.z = cvt_pk_bf16(hv[4], hv[5]); w.w = cvt_pk_bf16(hv[6], hv[7]);
                *(u32x4*)rowp = w; }
    }
};
struct EpiQKVRope {
    static constexpr bool PERM = true, AFTER_DRAIN = false;
    bf16_t* O; int ldc; const float* rope; float qscale;
    __device__ __forceinline__ void operator()(const f32x4 (&acc)[2][2][4][2], const Unit& u, int wr, int wc, int fr, int fq) const {
        const int b = u.pm / 33, tt = u.pm - b * 33; const bool dorope = (tt != 0) && (u.pn < 8); const float sc = (u.pn < 4) ? qscale : 1.0f;
        const int rl = wr * 64 + fr, col0 = u.pn * BM + wc * 32 + 8 * fq, i0 = (wc & 1) * 16 + 4 * fq;
#pragma unroll
        for (int ai = 0; ai < 2; ++ai)
#pragma unroll
            for (int m = 0; m < 4; ++m) { const int r = rl + ai * HALF + m * 16; bf16_t* rowp = O + (size_t)(u.pm * BM + r) * ldc + col0;
                f32x4 t0 = (f32x4){1.f, 0.f, 1.f, 0.f}, t1 = t0;
                if (dorope) { const int pos = tt * 256 - 256 + r; const int pp = (i0 < 16) ? (pos >> 6) : (pos & 63); const f32x4* tb = (const f32x4*)(rope + (pp * 16 + (i0 & 15)) * 2); t0 = tb[0]; t1 = tb[1]; }
#pragma unroll
                for (int bj = 0; bj < 2; ++bj) { const f32x4 v0 = acc[ai][bj][m][0], v1 = acc[ai][bj][m][1]; u32x4 w;
                    w.x = cvt_pk_bf16((v0[0] * t0[0] - v0[1] * t0[1]) * sc, (v0[0] * t0[1] + v0[1] * t0[0]) * sc);
                    w.y = cvt_pk_bf16((v0[2] * t0[2] - v0[3] * t0[3]) * sc, (v0[2] * t0[3] + v0[3] * t0[2]) * sc);
                    w.z = cvt_pk_bf16((v1[0] * t1[0] - v1[1] * t1[1]) * sc, (v1[0] * t1[1] + v1[1] * t1[0]) * sc);
                    w.w = cvt_pk_bf16((v1[2] * t1[2] - v1[3] * t1[3]) * sc, (v1[2] * t1[3] + v1[3] * t1[2]) * sc);
                    *(u32x4*)(rowp + bj * HALF) = w; } }
    }
};
struct EpiPartial {
    static constexpr bool PERM = false, AFTER_DRAIN = false;
    float* P;
    __device__ __forceinline__ void operator()(const f32x4 (&acc)[2][2][4][2], const Unit& u, int wr, int wc, int fr, int fq) const {
        const int col0 = u.pn * BM + wc * 32 + 4 * fq;
        float* dst = P + ((size_t)u.kc * 1024 + (u.pm / 33) * 256 + wr * 64 + fr) * 1024 + col0;
#pragma unroll
        for (int ai = 0; ai < 2; ++ai)
#pragma unroll
            for (int m = 0; m < 4; ++m) { float* p = dst + (size_t)(ai * HALF + m * 16) * 1024;
#pragma unroll
                for (int bj = 0; bj < 2; ++bj)
#pragma unroll
                    for (int n = 0; n < 2; ++n) *(f32x4*)(p + bj * HALF + n * 16) = acc[ai][bj][m][n];
                asm volatile("" ::: "memory"); }
    }
};
template <class Epi, class Sched, bool ALIGN_EPI = false, bool SP2 = false>
__device__ __forceinline__ void gemm_phase(PG8_LAS unsigned char* lds, const Gemm g, const Sched& S, const Epi& E) {
    int tid_ = threadIdx.x; asm volatile("" : "+v"(tid_));
    const int tid = tid_, wid = __builtin_amdgcn_readfirstlane(tid >> 6), lane = tid & 63, wr = wid >> 2, wc = wid & 3, fr = lane & 15, fq = lane >> 4;
    const int K = g.K, ld = g.ld; int nt_ = K / BK; if constexpr (Sched::OPAQUE_NT) asm volatile("" : "+s"(nt_));
    const int nt = nt_;
    unsigned voffA[2], voffB[2];
#pragma unroll
    for (int i = 0; i < 2; ++i) { int R, C; stage_rc(tid * 16 + i * 8192, R, C); const int Rb = Epi::PERM ? ((R & ~31) + perm32(R & 31)) : R;
        voffA[i] = (unsigned)(R * ld + C) * 2u; voffB[i] = (unsigned)(Rb * ld + C) * 2u; }
    const size_t kstep = (size_t)(BK * 2);
    const size_t hstep = (size_t)HALF * ld * 2;
    const size_t tstep = 2 * hstep;
    const unsigned ldsw = (unsigned)wid * 1024u;
    const int aoff = lds_byte(wr * 64 + fr, fq * 8), boff = lds_byte(wc * 32 + fr, fq * 8);
#define PG8_SA(b, h) (((b) * 2 + (h)) * HTB)
#define PG8_SB(b, h) ((4 + (b) * 2 + (h)) * HTB)
#define PG8_STAGE(bufoff, gbase, voff) do { _Pragma("unroll") for (int _i = 0; _i < 2; ++_i) \
        __builtin_amdgcn_global_load_lds((const unsigned*)((const char*)(gbase) + (voff)[_i]), (PG8_LAS unsigned*)(lds + (bufoff) + ldsw + _i * 8192), 16, 0, 0); } while (0)
#define PG8_LDA(dst, b, h) do { _Pragma("unroll") for (int m = 0; m < 4; ++m) _Pragma("unroll") for (int k = 0; k < 2; ++k) dst[m][k] = *(const PG8_LAS bf16x8*)(lds + PG8_SA(b, h) + aoff + m * 2048 + k * 1024); } while (0)
#define PG8_LDB(dst, b, h) do { _Pragma("unroll") for (int n = 0; n < 2; ++n) _Pragma("unroll") for (int k = 0; k < 2; ++k) dst[n][k] = *(const PG8_LAS bf16x8*)(lds + PG8_SB(b, h) + boff + n * 2048 + k * 1024); } while (0)
#define PG8_MMA(ai, bj, At, Bt) do { __builtin_amdgcn_s_setprio(1); _Pragma("unroll") for (int m = 0; m < 4; ++m) _Pragma("unroll") for (int n = 0; n < 2; ++n) _Pragma("unroll") for (int k = 0; k < 2; ++k) \
        acc[ai][bj][m][n] = __builtin_amdgcn_mfma_f32_16x16x32_bf16(Bt[n][k], At[m][k], acc[ai][bj][m][n], 0, 0, 0); __builtin_amdgcn_s_setprio(0); } while (0)
#define PG8_WAIT_V(n) asm volatile("s_waitcnt vmcnt(" #n ")" ::: "memory")
#define PG8_WAIT_L(n) asm volatile("s_waitcnt lgkmcnt(" #n ")" ::: "memory")
#define PG8_BAR __builtin_amdgcn_s_barrier()
#define PG8_SCHED __builtin_amdgcn_sched_barrier(0)
    Unit cur, nxt; int ui = 0;
    if (!S.next(0, cur)) return;
    f32x4 acc[2][2][4][2];
#pragma unroll
    for (int a = 0; a < 2; ++a)
#pragma unroll
        for (int b = 0; b < 2; ++b)
#pragma unroll
            for (int m = 0; m < 4; ++m)
#pragma unroll
                for (int n = 0; n < 2; ++n) acc[a][b][m][n] = (f32x4){0.f, 0.f, 0.f, 0.f};
    bf16x8 At[4][2], B0[2][2], B1[2][2];
    const size_t cstep = (size_t)K * 2;
    const char* cA = (const char*)g.A + (size_t)cur.pm * tstep + (size_t)cur.kc * cstep; const char* cB = (const char*)g.Bt + (size_t)cur.pn * tstep + (size_t)cur.kc * cstep;
    S.a_ready(cur);
    if constexpr (SP2) {
        PG8_STAGE(PG8_SB(0, 0), cB, voffB); PG8_STAGE(PG8_SB(0, 1), cB + hstep, voffB); PG8_STAGE(PG8_SA(0, 0), cA, voffA); PG8_STAGE(PG8_SA(0, 1), cA + hstep, voffA);
        if (wr == 1) PG8_BAR;
        PG8_WAIT_V(2); PG8_BAR;
        PG8_STAGE(PG8_SB(1, 0), cB + kstep, voffB); PG8_STAGE(PG8_SA(1, 0), cA + kstep, voffA); PG8_STAGE(PG8_SB(1, 1), cB + hstep + kstep, voffB);
        PG8_WAIT_V(6); PG8_BAR;
    } else {
        PG8_STAGE(PG8_SB(0, 0), cB, voffB); PG8_STAGE(PG8_SA(0, 0), cA, voffA); PG8_STAGE(PG8_SB(0, 1), cB + hstep, voffB); PG8_STAGE(PG8_SA(0, 1), cA + hstep, voffA);
        if (wr == 1) PG8_BAR;
        PG8_WAIT_V(4); PG8_BAR;
        PG8_STAGE(PG8_SB(1, 0), cB + kstep, voffB); PG8_STAGE(PG8_SA(1, 0), cA + kstep, voffA); PG8_STAGE(PG8_SB(1, 1), cB + hstep + kstep, voffB);
        PG8_WAIT_V(6); PG8_BAR;
    }
    for (;;) {
        const bool has_next = S.next(ui + 1, nxt);
        const char* nA = has_next ? (const char*)g.A + (size_t)nxt.pm * tstep + (size_t)nxt.kc * cstep : cA; const char* nB = has_next ? (const char*)g.Bt + (size_t)nxt.pn * tstep + (size_t)nxt.kc * cstep : cB;
        for (int t = 0; t < nt; t += 2) {
            const bool last = (t == nt - 2);
            const char* a1 = cA + (size_t)(t + 1) * kstep;
            const char* a2 = last ? nA : cA + (size_t)(t + 2) * kstep; const char* b2 = last ? nB : cB + (size_t)(t + 2) * kstep;
            const char* a3 = a2 + kstep; const char* b3 = b2 + kstep;
            if (last && has_next) S.a_ready(nxt);
            if constexpr (SP2) {
            PG8_LDB(B0, 0, 0); PG8_LDB(B1, 0, 1); PG8_SCHED; PG8_LDA(At, 0, 0); PG8_STAGE(PG8_SA(1, 1), a1 + hstep, voffA);
            PG8_WAIT_V(8); PG8_WAIT_L(0); PG8_BAR; PG8_MMA(0, 0, At, B0); PG8_MMA(0, 1, At, B1); PG8_BAR; PG8_SCHED;
            PG8_LDA(At, 0, 1); PG8_STAGE(PG8_SB(0, 0), b2, voffB); PG8_STAGE(PG8_SB(0, 1), b2 + hstep, voffB); PG8_STAGE(PG8_SA(0, 0), a2, voffA);
            PG8_WAIT_V(8); PG8_WAIT_L(0); PG8_BAR; PG8_MMA(1, 0, At, B0); PG8_MMA(1, 1, At, B1); PG8_BAR; PG8_SCHED;
            PG8_LDB(B0, 1, 0); PG8_LDB(B1, 1, 1); PG8_SCHED; PG8_LDA(At, 1, 0); PG8_STAGE(PG8_SA(0, 1), a2 + hstep, voffA);
            PG8_WAIT_V(8); PG8_WAIT_L(0); PG8_BAR; PG8_MMA(0, 0, At, B0); PG8_MMA(0, 1, At, B1); PG8_BAR; PG8_SCHED;
            PG8_LDA(At, 1, 1); PG8_STAGE(PG8_SB(1, 0), b3, voffB); PG8_STAGE(PG8_SB(1, 1), b3 + hstep, voffB); PG8_STAGE(PG8_SA(1, 0), a3, voffA);
            PG8_WAIT_V(8); PG8_WAIT_L(0); PG8_BAR; PG8_MMA(1, 0, At, B0); PG8_MMA(1, 1, At, B1); PG8_BAR; PG8_SCHED;
            } else {
            PG8_LDB(B0, 0, 0); PG8_SCHED; PG8_LDA(At, 0, 0); PG8_STAGE(PG8_SA(1, 1), a1 + hstep, voffA);
            PG8_WAIT_L(8); PG8_BAR; PG8_WAIT_L(0); PG8_MMA(0, 0, At, B0); PG8_BAR; PG8_SCHED;
            PG8_LDB(B1, 0, 1); PG8_STAGE(PG8_SB(0, 0), b2, voffB);
            PG8_BAR; PG8_WAIT_L(0); PG8_MMA(0, 1, At, B1); PG8_BAR;
            PG8_LDA(At, 0, 1); PG8_STAGE(PG8_SA(0, 0), a2, voffA);
            PG8_BAR; PG8_WAIT_L(0); PG8_MMA(1, 0, At, B0); PG8_BAR; PG8_SCHED;
            PG8_STAGE(PG8_SB(0, 1), b2 + hstep, voffB);
            PG8_WAIT_V(6); PG8_BAR; PG8_MMA(1, 1, At, B1); PG8_BAR;
            PG8_LDB(B0, 1, 0); PG8_SCHED; PG8_LDA(At, 1, 0); PG8_STAGE(PG8_SA(0, 1), a2 + hstep, voffA);
            PG8_WAIT_L(8); PG8_BAR; PG8_WAIT_L(0); PG8_MMA(0, 0, At, B0); PG8_BAR; PG8_SCHED;
            PG8_LDB(B1, 1, 1); PG8_STAGE(PG8_SB(1, 0), b3, voffB);
            PG8_BAR; PG8_WAIT_L(0); PG8_MMA(0, 1, At, B1); PG8_BAR;
            PG8_LDA(At, 1, 1); PG8_STAGE(PG8_SA(1, 0), a3, voffA);
            PG8_BAR; PG8_WAIT_L(0); PG8_MMA(1, 0, At, B0); PG8_BAR; PG8_SCHED;
            PG8_STAGE(PG8_SB(1, 1), b3 + hstep, voffB);
            PG8_WAIT_V(6); PG8_BAR; PG8_MMA(1, 1, At, B1); PG8_BAR;
            }
        }
        if constexpr (ALIGN_EPI) { if (wr == 0) PG8_BAR; }
        if constexpr (!Epi::AFTER_DRAIN) { E(acc, cur, wr, wc, fr, fq); S.done(cur); }
        if (!has_next) break;
#pragma unroll
        for (int a = 0; a < 2; ++a)
#pragma unroll
            for (int b = 0; b < 2; ++b)
#pragma unroll
                for (int m = 0; m < 4; ++m)
#pragma unroll
                    for (int n = 0; n < 2; ++n) acc[a][b][m][n] = (f32x4){0.f, 0.f, 0.f, 0.f};
        cur = nxt; cA = nA; cB = nB; ++ui;
        if constexpr (ALIGN_EPI) { if (wr == 1) PG8_BAR; }
    }
    PG8_WAIT_V(0);
    if constexpr (!ALIGN_EPI) { if (wr == 0) PG8_BAR; }
    PG8_BAR;
    if constexpr (Epi::AFTER_DRAIN) { E.fused(acc, cur, wr, wc, fr, fq, lds, wid, lane); S.done(cur); }
#undef PG8_SA
#undef PG8_SB
#undef PG8_STAGE
#undef PG8_LDA
#undef PG8_LDB
#undef PG8_MMA
#undef PG8_WAIT_V
#undef PG8_WAIT_L
#undef PG8_BAR
#undef PG8_SCHED
}
}

#ifndef PG8_SP2
#define PG8_SP2 true
#endif
#ifndef PG8_ALIGN
#define PG8_ALIGN true
#endif
#include <hip/hip_bf16.h>
#include <cmath>
namespace attn_body {
using bf16=__hip_bfloat16;
using bf16x8=__attribute__((ext_vector_type(8)))short;
using s16x4=__attribute__((ext_vector_type(4)))short;
using f32x16=__attribute__((ext_vector_type(16)))float;
using u32x4=__attribute__((ext_vector_type(4)))unsigned;
constexpr int D=64;
constexpr int NW=8,QBLK=32,QB=QBLK*NW,KVBLK=64;
constexpr int ATTN_UNIT_ROWS=QB;
__device__ __forceinline__ int crow(int r,int hi){return (r&3)+8*(r>>2)+4*hi;}
#define SBAR() __builtin_amdgcn_sched_barrier(0)
typedef __attribute__((address_space(3))) const float* lds_cfptr;
__device__ __forceinline__ void namask(f32x16&p0,f32x16&p1,int t,int nabase,int r,int c,int hi,lds_cfptr tb){
  const float NEG=-INFINITY; const int kr=nabase+t-4; int rs=r-4; rs=rs<0?0:(rs>120?120:rs);
  if(kr<rs||kr>=rs+8){
    #pragma unroll
    for(int rr=0;rr<16;++rr){p0[rr]=NEG;p1[rr]=NEG;}
    return; }
  int cs=c-8; cs=cs<0?0:(cs>48?48:cs);
  const int rowi=(kr-r+7)*31+15-c;
  #pragma unroll
  for(int rr=0;rr<16;++rr){ const int j=(rr&3)+8*(rr>>2)+4*hi, j1=j+32;
    const bool v0=(j>=cs)&&(j<cs+16), v1=(j1>=cs)&&(j1<cs+16);
    const float b0=tb[v0?rowi+j:0], b1=tb[v1?rowi+j1:0];
    p0[rr]=v0?p0[rr]+b0:NEG; p1[rr]=v1?p1[rr]+b1:NEG; }
}

typedef unsigned u32x4_t __attribute__((ext_vector_type(4)));
__device__ __forceinline__ bool na_rowok(int t,int nabase,int r){ const int kr=nabase+t-4; int rs=r-4; rs=rs<0?0:(rs>120?120:rs); return kr>=rs&&kr<rs+8; }
__device__ __forceinline__ void na_mfload(u32x4_t*mf,const unsigned*mfh,int t,int nabase,int r,int chalf,int lane){
  const int dr=nabase+t-4-r+7; const u32x4_t*p=(const u32x4_t*)(mfh+(size_t)(((dr*2+chalf)*64+lane)*16));
  #pragma unroll
  for(int i=0;i<4;++i)mf[i]=p[i];
}
__device__ __forceinline__ void na_apply(f32x16&p0,f32x16&p1,const u32x4_t*mf,bool ok){
  if(!ok){ const float NEG=-INFINITY;
    #pragma unroll
    for(int rr=0;rr<16;++rr){p0[rr]=NEG;p1[rr]=NEG;}
    return; }
  #pragma unroll
  for(int rr=0;rr<16;++rr){ const unsigned w0=mf[rr>>3][(rr>>1)&3], w1=mf[2+(rr>>3)][(rr>>1)&3];
    p0[rr]+=__builtin_bit_cast(float,(rr&1)?(w0&0xffff0000u):(w0<<16)); p1[rr]+=__builtin_bit_cast(float,(rr&1)?(w1&0xffff0000u):(w1<<16)); }
}

constexpr int NSLOT=3, SLOTB=8192, VSLOTB=2*SLOTB;
constexpr int LDS_K=0, LDS_V=NSLOT*SLOTB, LDS_WS=LDS_V+NSLOT*VSLOTB, LDS_OST=LDS_WS+NW*64*4, LDS_TB=LDS_OST+NW*4096, LDS_BYTES=LDS_TB+2048;
constexpr float C2=0.125f*1.4426950408889634f;
__device__ __forceinline__ void glds16(const void*gsrc,unsigned lds_dst){unsigned keep;
  asm volatile("s_mov_b32 %0, m0\n\ts_mov_b32 m0, %2\n\ts_nop 0\n\tglobal_load_lds_dwordx4 %1, off\n\ts_mov_b32 m0, %0":"=&s"(keep):"v"(gsrc),"s"(lds_dst):"memory");}
__device__ __forceinline__ float max3f(float a,float b,float c){float r;asm("v_max3_f32 %0, %1, %2, %3":"=v"(r):"v"(a),"v"(b),"v"(c));return r;}
__device__ __forceinline__ float max2f(float a,float b){float r;asm("v_max_f32_e32 %0, %1, %2":"=v"(r):"v"(a),"v"(b));return r;}
__device__ __forceinline__ float fadd_s(float a,float b){float r;asm("v_add_f32_e32 %0, %1, %2":"=v"(r):"v"(a),"v"(b));return r;}
__device__ __forceinline__ float fsub_s(float a,float b){float r;asm("v_sub_f32_e32 %0, %1, %2":"=v"(r):"v"(a),"v"(b));return r;}
typedef float f32x2_t __attribute__((ext_vector_type(2))); typedef __bf16 bf16x2_t __attribute__((ext_vector_type(2)));
__device__ __forceinline__ unsigned cvtpk_s(float lo,float hi){f32x2_t v={lo,hi};bf16x2_t b=__builtin_convertvector(v,bf16x2_t);return __builtin_bit_cast(unsigned,b);}
#define WAIT_BAR(N) asm volatile("s_waitcnt vmcnt(" #N ") lgkmcnt(0)\n\ts_barrier":::"memory")

__device__ __forceinline__ void qkt(f32x16&p0,f32x16&p1,const char*Kslot,const bf16x8*qr,const f32x16&negm,int r32,int hi){
  const char*kb=Kslot+hi*1024+r32*16;
  #pragma unroll
  for(int d0=0;d0<4;++d0){
    const bf16x8 b0=*reinterpret_cast<const bf16x8*>(kb+d0*2048);
    const bf16x8 b1=*reinterpret_cast<const bf16x8*>(kb+d0*2048+512);
    if(d0==0){p0=__builtin_amdgcn_mfma_f32_32x32x16_bf16(b0,qr[0],negm,0,0,0);p1=__builtin_amdgcn_mfma_f32_32x32x16_bf16(b1,qr[0],negm,0,0,0);}
    else{p0=__builtin_amdgcn_mfma_f32_32x32x16_bf16(b0,qr[d0],p0,0,0,0);p1=__builtin_amdgcn_mfma_f32_32x32x16_bf16(b1,qr[d0],p1,0,0,0);}}
}
typedef __attribute__((address_space(3))) const char* lds_cptr;
typedef short v4i16_t __attribute__((ext_vector_type(4)));
__device__ __forceinline__ void kload8(bf16x8*kf,lds_cptr kp){
  kf[0]=*(const __attribute__((address_space(3))) bf16x8*)(kp);      kf[1]=*(const __attribute__((address_space(3))) bf16x8*)(kp+512);
  kf[2]=*(const __attribute__((address_space(3))) bf16x8*)(kp+2048); kf[3]=*(const __attribute__((address_space(3))) bf16x8*)(kp+2560);
  kf[4]=*(const __attribute__((address_space(3))) bf16x8*)(kp+4096); kf[5]=*(const __attribute__((address_space(3))) bf16x8*)(kp+4608);
  kf[6]=*(const __attribute__((address_space(3))) bf16x8*)(kp+6144); kf[7]=*(const __attribute__((address_space(3))) bf16x8*)(kp+6656);
}
__device__ __forceinline__ void kload2(bf16x8*kf,lds_cptr kp,int j){ kf[2*j]=*(const __attribute__((address_space(3))) bf16x8*)(kp+j*2048); kf[2*j+1]=*(const __attribute__((address_space(3))) bf16x8*)(kp+j*2048+512); }
__device__ __forceinline__ s16x4 vtr(lds_cptr p){ return __builtin_bit_cast(s16x4,__builtin_amdgcn_ds_read_tr16_b64_v4i16((__attribute__((address_space(3))) v4i16_t*)p)); }
__device__ __forceinline__ float rowmax(const f32x16&p0,const f32x16&p1){
  float a=max3f(p0[0],p0[1],p1[0]),b=max3f(p0[2],p0[3],p1[1]);a=max3f(a,p1[2],p1[3]);
  #pragma unroll
  for(int r=4;r<16;r+=4){a=max3f(a,p0[r],p0[r+1]);b=max3f(b,p0[r+2],p0[r+3]);a=max3f(a,p1[r],p1[r+1]);b=max3f(b,p1[r+2],p1[r+3]);}
  const float m=max2f(a,b);
  auto rr=__builtin_amdgcn_permlane32_swap(__float_as_uint(m),__float_as_uint(m),false,false);
  return max2f(__uint_as_float(rr[0]),__uint_as_float(rr[1]));
}
__device__ __forceinline__ void pv(f32x16*o,int vb,bf16x8 pa0,bf16x8 pa1,bf16x8 pa2,bf16x8 pa3){
  #pragma unroll
  for(int d0=0;d0<2;++d0){s16x4 lo[4],hi[4];
    #pragma unroll
    for(int ks=0;ks<4;++ks){
      asm volatile("ds_read_b64_tr_b16 %0,%1 offset:%c2":"=&v"(lo[ks]):"v"(vb),"i"(d0*4096+ks*1024):"memory");
      asm volatile("ds_read_b64_tr_b16 %0,%1 offset:%c2":"=&v"(hi[ks]):"v"(vb),"i"(d0*4096+ks*1024+512):"memory");}
    asm volatile("s_waitcnt lgkmcnt(0)":::"memory");SBAR();
    #define PK(k) (bf16x8){lo[k][0],lo[k][1],lo[k][2],lo[k][3],hi[k][0],hi[k][1],hi[k][2],hi[k][3]}
    o[d0]=__builtin_amdgcn_mfma_f32_32x32x16_bf16(pa0,PK(0),o[d0],0,0,0);
    o[d0]=__builtin_amdgcn_mfma_f32_32x32x16_bf16(pa1,PK(1),o[d0],0,0,0);
    o[d0]=__builtin_amdgcn_mfma_f32_32x32x16_bf16(pa2,PK(2),o[d0],0,0,0);
    o[d0]=__builtin_amdgcn_mfma_f32_32x32x16_bf16(pa3,PK(3),o[d0],0,0,0);
    #undef PK
  }
}

#ifndef ATTN_STORE16
#define ATTN_STORE16(p,v) (*(u32x4*)(p)=(v))
#endif
template<int MODE,int THRL> __device__ __forceinline__ void attn_unit(const bf16*Qw0,int PQ,const bf16*__restrict__ Kh,int PK,const bf16*__restrict__ Vh,int PV,bf16*Ow0,int PO,int NT,int nabase,int nar0,const float*rpbh,char*shm){
  int tid_=threadIdx.x; asm volatile("":"+v"(tid_));
  const int tid=tid_,lane=tid&63,r32=lane&31,hi=lane>>5; const int wid=__builtin_amdgcn_readfirstlane(tid>>6);
  const bf16*Qw=Qw0+(long)wid*QBLK*PQ;
  const unsigned lds0=(unsigned)(uintptr_t)shm;
  float*wsf=(float*)(shm+LDS_WS)+wid*64;
  const bf16*ksrc=Kh+(long)lane*PK+wid*8;
  const bf16*vsrc=Vh+(long)(16*(wid&3)+(lane>>2))*PV+(wid>>2)*32+(lane&3)*8;
  const unsigned kdst=lds0+LDS_K+wid*1024, vdst=lds0+LDS_V+wid*1024;
  #define KROW(t) ((t)*KVBLK+((MODE==1&&(t)>=4)?nabase*64:0))
  #define DMA_K(t,slot) glds16(ksrc+(long)KROW(t)*PK,(unsigned)__builtin_amdgcn_readfirstlane(kdst+(slot)))
  #define DMA_V(t,slot) do{ glds16(vsrc+(long)KROW(t)*PV,(unsigned)__builtin_amdgcn_readfirstlane(vdst+2*(slot))); if(MODE==2)glds16(vsrc+(long)KROW(t)*PV+64,(unsigned)__builtin_amdgcn_readfirstlane(vdst+2*(slot)+SLOTB)); }while(0)
  const int vb0=(int)(lds0+LDS_V)+((lane>>4)&1)*32+(lane&3)*8+(4*hi+((lane&15)>>2))*64;
  const char*Kbase=shm+LDS_K; bf16x8 kf[8];
  const lds_cptr shm3=(lds_cptr)shm; const lds_cptr kp0=shm3+LDS_K+hi*1024+r32*16; const lds_cptr vp0=shm3+LDS_V+((lane>>4)&1)*32+(lane&3)*8+(4*hi+((lane&15)>>2))*64;
  const lds_cfptr tb=(lds_cfptr)(shm3+LDS_TB);
  u32x4_t mf[4];
  const int nar=nar0+(wid>>1), nac=(wid&1)*32+r32;
  DMA_K(0,0);DMA_V(0,0);DMA_K(1,SLOTB);
  bf16x8 qr[4];
  #pragma unroll
  for(int d0=0;d0<4;++d0)qr[d0]=*reinterpret_cast<const bf16x8*>(&Qw[(long)r32*PQ+d0*16+hi*8]);
  float mhat=0.f,l_reg=0.f;constexpr int ND=(MODE==2)?4:2; f32x16 o[4];o[0]=f32x16{};o[1]=f32x16{};o[2]=f32x16{};o[3]=f32x16{};f32x16 negm=f32x16{};asm volatile("":"+v"(negm));
  #define CMASK(P0,P1,t) do{ if(MODE==1&&(t)>=4)na_apply(P0,P1,mf,na_rowok((t),nabase,nar)); }while(0)
  #define MFLOAD(tn) do{ if(MODE==1&&(tn)>=4&&(tn)<NT){ if(na_rowok((tn),nabase,nar))na_mfload(mf,(const unsigned*)rpbh,(tn),nabase,nar,wid&1,lane); } }while(0)
  bool resc=false;
  #define START(P0,P1) do{ const float rm=rowmax(P0,P1); resc=false; \
    { const float dl=rm; mhat=fadd_s(mhat,dl); \
      _Pragma("unroll") for(int r=0;r<16;++r){P0[r]=fsub_s(P0[r],dl);P1[r]=fsub_s(P1[r],dl);} \
      _Pragma("unroll") for(int r=0;r<16;++r)negm[r]=-mhat; asm volatile("":"+v"(negm)); } \
    _Pragma("unroll") for(int r=0;r<16;++r)P0[r]=__builtin_amdgcn_exp2f(P0[r]); }while(0)
  #define RESC() do{ if(resc){ asm volatile("s_waitcnt lgkmcnt(0)":::"memory"); \
      _Pragma("unroll") for(int d_=0;d_<ND;++d_) _Pragma("unroll") for(int r=0;r<16;++r)o[d_][r]*=wsf[crow(r,hi)]; } }while(0)
  f32x16 pA0,pA1,pB0,pB1;
  int sl_prev=0,sl_cur=0,sl_next=SLOTB;
  #define ROT() do{sl_prev=sl_cur;sl_cur=sl_next;sl_next=(sl_next==(NSLOT-1)*SLOTB)?0:sl_next+SLOTB;}while(0)
  DMA_K(2,2*SLOTB);
  if(MODE==2){WAIT_BAR(4);}else{WAIT_BAR(3);}
  qkt(pA0,pA1,Kbase,qr,negm,r32,hi);asm volatile("s_nop 15\n\ts_nop 7":"+v"(pA0),"+v"(pA1));CMASK(pA0,pA1,0);
  START(pA0,pA1);
  _Pragma("unroll") for(int r=0;r<16;++r)pA1[r]=__builtin_amdgcn_exp2f(pA1[r]);
  WAIT_BAR(0);
  DMA_K(3,0);DMA_V(1,SLOTB);
  ROT();
  kload8(kf,kp0+sl_cur);
  if(MODE==2){WAIT_BAR(3);}else{WAIT_BAR(2);}
  s16x4 vlo[8],vhi[8]; u32x4 pw0,pw1,pw2,pw3;
  #define PKW(P,B) cvtpk_s(P[B],P[B+1])
  #define PAF(k) __builtin_bit_cast(bf16x8,pw##k)
  #define VFR(i) (bf16x8){vlo[i][0],vlo[i][1],vlo[i][2],vlo[i][3],vhi[i][0],vhi[i][1],vhi[i][2],vhi[i][3]}
  #define PIN(x) asm volatile("":"+v"(x))
  #define MX3(a,b,c) __builtin_fmaxf(__builtin_fmaxf((a),(b)),(c))
  #define GAPA(MF,A0,A1,A2,A3,W0,W1,PW) do{ MF; sacc+=A0; sacc+=A1; sacc+=A2; sacc+=A3; PIN(sacc); W0; W1; PIN(PW); SBAR(); }while(0)
  #define EX(v) __builtin_amdgcn_exp2f(v)
  #define GAPB(MF,X,B) do{ MF; X[B]=EX(X[B]); X[B+1]=EX(X[B+1]); X[B+2]=EX(X[B+2]); X[B+3]=EX(X[B+3]); PIN(X); SBAR(); }while(0)
  #define GAPB2(MF,X,B) do{ MF; X[B]=EX(X[B]); X[B+1]=EX(X[B+1]); PIN(X); SBAR(); }while(0)
  #define GAPB3(MF,X,A,Y,B,Z,C) do{ MF; X[A]=EX(X[A]); Y[B]=EX(Y[B]); Z[C]=EX(Z[C]); PIN(X); PIN(Z); SBAR(); }while(0)
  #define VRD(i) do{ vlo[i]=vtr(vp_+(((i)>>2)*4096+((i)&3)*1024)); vhi[i]=vtr(vp_+(((i)>>2)*4096+((i)&3)*1024+512)); }while(0)
  #define VRD2(i) do{ if(MODE==2){ vlo[i]=vtr(vp_+(SLOTB+((i)>>2)*4096+((i)&3)*1024)); vhi[i]=vtr(vp_+(SLOTB+((i)>>2)*4096+((i)&3)*1024+512)); SBAR(); } }while(0)
  #define KRD(G,j) do{ if(G){ kload2(kf,kp0+sl_next,j); SBAR(); } }while(0)
  #define STEP(C0,C1,P0,P1,t,GK,GV,GL) do{ SBAR(); \
    const lds_cptr vp_=vp0+2*sl_prev; \
    VRD(0); SBAR(); float sacc=(P0[0]+P0[1]); \
    GAPA(C0=__builtin_amdgcn_mfma_f32_32x32x16_bf16(kf[0],qr[0],negm,0,0,0), P0[2],P0[3],P0[4],P0[5],     pw0[0]=PKW(P0,0), pw0[1]=PKW(P0,2), pw0); \
    VRD(4); SBAR(); GAPA(C1=__builtin_amdgcn_mfma_f32_32x32x16_bf16(kf[1],qr[0],negm,0,0,0), P0[6],P0[7],P0[8],P0[9],     pw0[2]=PKW(P0,4), pw0[3]=PKW(P0,6), pw0); \
    VRD(1); SBAR(); GAPA(C0=__builtin_amdgcn_mfma_f32_32x32x16_bf16(kf[2],qr[1],C0,0,0,0),   P0[10],P0[11],P0[12],P0[13], pw1[0]=PKW(P0,8), pw1[1]=PKW(P0,10), pw1); \
    VRD(5); SBAR(); GAPA(C1=__builtin_amdgcn_mfma_f32_32x32x16_bf16(kf[3],qr[1],C1,0,0,0),   P0[14],P0[15],P1[0],P1[1],   pw1[2]=PKW(P0,12),pw1[3]=PKW(P0,14), pw1); \
    VRD(2); SBAR(); GAPA(C0=__builtin_amdgcn_mfma_f32_32x32x16_bf16(kf[4],qr[2],C0,0,0,0),   P1[2],P1[3],P1[4],P1[5],     pw2[0]=PKW(P1,0), pw2[1]=PKW(P1,2), pw2); \
    VRD(6); SBAR(); GAPA(C1=__builtin_amdgcn_mfma_f32_32x32x16_bf16(kf[5],qr[2],C1,0,0,0),   P1[6],P1[7],P1[8],P1[9],     pw2[2]=PKW(P1,4), pw2[3]=PKW(P1,6), pw2); \
    VRD(3); SBAR(); GAPA(C0=__builtin_amdgcn_mfma_f32_32x32x16_bf16(kf[6],qr[3],C0,0,0,0),   P1[10],P1[11],P1[12],P1[13], pw3[0]=PKW(P1,8), pw3[1]=PKW(P1,10), pw3); \
    VRD(7); SBAR(); GAPA(C1=__builtin_amdgcn_mfma_f32_32x32x16_bf16(kf[7],qr[3],C1,0,0,0),   P1[14],P1[15],0.f,0.f,       pw3[2]=PKW(P1,12),pw3[3]=PKW(P1,14), pw3); \
    l_reg+=sacc; \
    CMASK(C0,C1,t); MFLOAD((t)+1); \
    if(GK){DMA_K((t)+3,sl_cur);} if(GV){DMA_V((t)+1,sl_next);} \
    if(MODE==2){   \
      o[0]=__builtin_amdgcn_mfma_f32_32x32x16_bf16(PAF(0),VFR(0),o[0],0,0,0); VRD2(0); \
      o[1]=__builtin_amdgcn_mfma_f32_32x32x16_bf16(PAF(0),VFR(4),o[1],0,0,0); VRD2(4); \
      o[0]=__builtin_amdgcn_mfma_f32_32x32x16_bf16(PAF(1),VFR(1),o[0],0,0,0); VRD2(1); } \
    { float a=MX3(C0[0],C0[1],C1[0]),b=MX3(C0[2],C0[3],C1[1]); a=MX3(a,C1[2],C1[3]); \
      _Pragma("unroll") for(int r=4;r<16;r+=4){a=MX3(a,C0[r],C0[r+1]);b=MX3(b,C0[r+2],C0[r+3]);a=MX3(a,C1[r],C1[r+1]);b=MX3(b,C1[r+2],C1[r+3]);} \
      float rm=__builtin_fmaxf(a,b); { auto rr=__builtin_amdgcn_permlane32_swap(__float_as_uint(rm),__float_as_uint(rm),false,false); rm=__builtin_fmaxf(__uint_as_float(rr[0]),__uint_as_float(rr[1])); } \
      resc=false; \
      if(__builtin_expect(__any(rm>(float)THRL),0)){ const float dl=__builtin_fmaxf(rm,0.f); mhat+=dl; \
        _Pragma("unroll") for(int r=0;r<16;++r){C0[r]-=dl;C1[r]-=dl;} \
        _Pragma("unroll") for(int r=0;r<16;++r)negm[r]=-mhat; asm volatile("":"+v"(negm)); \
        const float f=__builtin_amdgcn_exp2f(-dl); l_reg*=f; if(hi==0)wsf[r32]=f; resc=true; } } \
    SBAR(); \
    if(MODE!=2){ \
    GAPB(o[0]=__builtin_amdgcn_mfma_f32_32x32x16_bf16(PAF(0),VFR(0),o[0],0,0,0), C0,0); \
    GAPB(o[1]=__builtin_amdgcn_mfma_f32_32x32x16_bf16(PAF(0),VFR(4),o[1],0,0,0), C0,4); \
    KRD(GL,0); GAPB(o[0]=__builtin_amdgcn_mfma_f32_32x32x16_bf16(PAF(1),VFR(1),o[0],0,0,0), C0,8); \
    KRD(GL,1); GAPB(o[1]=__builtin_amdgcn_mfma_f32_32x32x16_bf16(PAF(1),VFR(5),o[1],0,0,0), C0,12); \
    KRD(GL,2); GAPB(o[0]=__builtin_amdgcn_mfma_f32_32x32x16_bf16(PAF(2),VFR(2),o[0],0,0,0), C1,0); \
    KRD(GL,3); GAPB(o[1]=__builtin_amdgcn_mfma_f32_32x32x16_bf16(PAF(2),VFR(6),o[1],0,0,0), C1,4); \
    GAPB(o[0]=__builtin_amdgcn_mfma_f32_32x32x16_bf16(PAF(3),VFR(3),o[0],0,0,0), C1,8); \
    GAPB(o[1]=__builtin_amdgcn_mfma_f32_32x32x16_bf16(PAF(3),VFR(7),o[1],0,0,0), C1,12); \
    } else {   \
    KRD(GL,0); GAPB3(o[1]=__builtin_amdgcn_mfma_f32_32x32x16_bf16(PAF(1),VFR(5),o[1],0,0,0), C0,0,C0,1,C0,2); VRD2(5); \
    KRD(GL,1); GAPB3(o[0]=__builtin_amdgcn_mfma_f32_32x32x16_bf16(PAF(2),VFR(2),o[0],0,0,0), C0,3,C0,4,C0,5); VRD2(2); \
    KRD(GL,2); GAPB3(o[1]=__builtin_amdgcn_mfma_f32_32x32x16_bf16(PAF(2),VFR(6),o[1],0,0,0), C0,6,C0,7,C0,8); VRD2(6); \
    KRD(GL,3); GAPB3(o[0]=__builtin_amdgcn_mfma_f32_32x32x16_bf16(PAF(3),VFR(3),o[0],0,0,0), C0,9,C0,10,C0,11); VRD2(3); \
    GAPB3(o[1]=__builtin_amdgcn_mfma_f32_32x32x16_bf16(PAF(3),VFR(7),o[1],0,0,0), C0,12,C0,13,C0,14); VRD2(7); \
    GAPB3(o[2]=__builtin_amdgcn_mfma_f32_32x32x16_bf16(PAF(0),VFR(0),o[2],0,0,0), C0,15,C1,0,C1,1); \
    GAPB2(o[3]=__builtin_amdgcn_mfma_f32_32x32x16_bf16(PAF(0),VFR(4),o[3],0,0,0), C1,2); \
    GAPB2(o[2]=__builtin_amdgcn_mfma_f32_32x32x16_bf16(PAF(1),VFR(1),o[2],0,0,0), C1,4); \
    GAPB2(o[3]=__builtin_amdgcn_mfma_f32_32x32x16_bf16(PAF(1),VFR(5),o[3],0,0,0), C1,6); \
    GAPB2(o[2]=__builtin_amdgcn_mfma_f32_32x32x16_bf16(PAF(2),VFR(2),o[2],0,0,0), C1,8); \
    GAPB2(o[3]=__builtin_amdgcn_mfma_f32_32x32x16_bf16(PAF(2),VFR(6),o[3],0,0,0), C1,10); \
    GAPB2(o[2]=__builtin_amdgcn_mfma_f32_32x32x16_bf16(PAF(3),VFR(3),o[2],0,0,0), C1,12); \
    GAPB2(o[3]=__builtin_amdgcn_mfma_f32_32x32x16_bf16(PAF(3),VFR(7),o[3],0,0,0), C1,14); \
    } \
    }while(0)
  int t=1;
  for(;t+5<NT;t+=2){
    STEP(pB0,pB1,pA0,pA1,t,true,true,true);     if(MODE==2){WAIT_BAR(3);}else{WAIT_BAR(2);} RESC(); ROT();
    STEP(pA0,pA1,pB0,pB1,t+1,true,true,true);   if(MODE==2){WAIT_BAR(3);}else{WAIT_BAR(2);} RESC(); ROT();
  }
  #define CMASK_DUP(P0,P1,t) do{ if(MODE==1&&(t)>=4)namask(P0,P1,(t),nabase,nar,nac,hi,tb); }while(0)
  #define ENDW(tt) do{ if((tt)+3<NT){ if(MODE==2){WAIT_BAR(3);}else{WAIT_BAR(2);} } else if((tt)+2<NT){ if(MODE==2){WAIT_BAR(2);}else{WAIT_BAR(1);} } else {WAIT_BAR(0);} }while(0)
  for(;t+1<NT;t+=2){
    STEP(pB0,pB1,pA0,pA1,t,(t+3<NT),(t+1<NT),(t+1<NT));       ENDW(t);   RESC(); ROT();
    STEP(pA0,pA1,pB0,pB1,t+1,(t+4<NT),(t+2<NT),(t+2<NT));     ENDW(t+1); RESC(); ROT();
  }
  STEP(pB0,pB1,pA0,pA1,NT-1,false,false,false); RESC();
  { float sacc=pB0[0]+pB0[1]; _Pragma("unroll") for(int r=2;r<16;++r)sacc+=pB0[r]; _Pragma("unroll") for(int r=0;r<16;++r)sacc+=pB1[r]; l_reg+=sacc;
    pw0=(u32x4){PKW(pB0,0),PKW(pB0,2),PKW(pB0,4),PKW(pB0,6)};pw1=(u32x4){PKW(pB0,8),PKW(pB0,10),PKW(pB0,12),PKW(pB0,14)};pw2=(u32x4){PKW(pB1,0),PKW(pB1,2),PKW(pB1,4),PKW(pB1,6)};pw3=(u32x4){PKW(pB1,8),PKW(pB1,10),PKW(pB1,12),PKW(pB1,14)};
    SBAR(); pv(o,vb0+2*sl_cur,PAF(0),PAF(1),PAF(2),PAF(3)); if(MODE==2){ SBAR(); pv(o+2,vb0+2*sl_cur+SLOTB,PAF(0),PAF(1),PAF(2),PAF(3)); } }
  #undef PKW
  #undef PAF
  #undef VFR
  #undef PIN
  #undef MX3
  #undef GAPA
  #undef GAPB
  #undef GAPB2
  #undef GAPB3
  #undef EX
  #undef VRD
  #undef VRD2
  #undef KRD
  #undef STEP
  #undef ENDW
  {auto rr=__builtin_amdgcn_permlane32_swap(__float_as_uint(l_reg),__float_as_uint(l_reg),false,false);l_reg=__uint_as_float(rr[0])+__uint_as_float(rr[1]);}
  if(hi==0)wsf[32+r32]=l_reg;asm volatile("s_waitcnt lgkmcnt(0)":::"memory");
  float rli[16];
  #pragma unroll
  for(int r=0;r<16;++r)rli[r]=__builtin_amdgcn_rcpf(wsf[32+crow(r,hi)]);
  bf16*Ow=Ow0+(long)wid*QBLK*PO;
  { bf16*stg=(bf16*)(shm+LDS_OST)+wid*2048;
    #pragma unroll
    for(int hf=0;hf<ND/2;++hf){
    #pragma unroll
    for(int r=0;r<16;++r){const int orow=crow(r,hi);
      #pragma unroll
      for(int d0=0;d0<2;++d0)stg[orow*64+d0*32+r32]=__float2bfloat16(o[2*hf+d0][r]*rli[r]);}
    asm volatile("s_waitcnt lgkmcnt(0)":::"memory");
    #pragma unroll
    for(int i=0;i<4;++i){const int row=i*8+(lane>>3),ch=lane&7; const u32x4 v=*(const u32x4*)(stg+row*64+ch*8); ATTN_STORE16(Ow+(long)row*PO+hf*64+ch*8,v);}
    asm volatile("s_waitcnt lgkmcnt(0)":::"memory"); } }
  asm volatile("s_waitcnt lgkmcnt(0)\n\ts_barrier":::"memory");
  #undef DMA_K
  #undef DMA_V
  #undef KROW
  #undef CMASK_DUP
  #undef CMASK
  #undef MFLOAD
  #undef START
  #undef RESC
  #undef ROT
}
constexpr int ATTN_LDS_BYTES=LDS_BYTES;
#undef SBAR
#undef WAIT_BAR
}
constexpr int DMODEL = 1024, NBATCH = 4, SEQ = 8192, CTXL = 256, TPB = SEQ + CTXL  , MROWS = NBATCH * TPB  , DFF = 2816;
constexpr int PAR_IN = 2304, DIFF_IN = 3072, NMOD6 = 6 * DMODEL;
constexpr float EPS = 1e-6f;
constexpr float LAMBDA_INIT = 0.35550906759096925f;
constexpr int NWAVES = 8, NTHREADS = NWAVES * 64;
constexpr size_t WS_W_IN0 = 0;
constexpr size_t WS_W_OUT0 = WS_W_IN0 + (size_t)PAR_IN * DMODEL * 2;
constexpr size_t WS_W_GU0 = WS_W_OUT0 + (size_t)DMODEL * DMODEL * 2;
constexpr size_t WS_W_DN0 = WS_W_GU0 + (size_t)2 * DFF * DMODEL * 2;
constexpr size_t WS_W_IN1 = WS_W_DN0 + (size_t)DMODEL * DFF * 2;
constexpr size_t WS_W_OUT1 = WS_W_IN1 + (size_t)DIFF_IN * DMODEL * 2;
constexpr size_t WS_W_GU1 = WS_W_OUT1 + (size_t)DMODEL * DMODEL * 2;
constexpr size_t WS_W_DN1 = WS_W_GU1 + (size_t)2 * DFF * DMODEL * 2;
constexpr size_t WS_MOD = WS_W_DN1 + (size_t)DMODEL * DFF * 2;
constexpr size_t WS_ROPE = WS_MOD + (size_t)2 * 5 * NMOD6 * 4;
constexpr size_t WS_X = WS_ROPE + (size_t)128 * 16 * 2 * 4;
constexpr size_t WS_XN = WS_X + (size_t)MROWS * DMODEL * 4;
constexpr size_t WS_QKV = WS_XN + (size_t)MROWS * DMODEL * 2;
constexpr size_t WS_END = WS_QKV + (size_t)MROWS * DIFF_IN * 2;
constexpr size_t WS_PART = WS_END + 65536;
static_assert(WS_PART + (size_t)11 * 1024 * 1024 * 4 <= (size_t)512 * 1024 * 1024, "d_ws map");
constexpr size_t WS_MF = WS_PART + (size_t)11 * 1024 * 1024 * 4;
static_assert(WS_MF + (size_t)8 * 15 * 2 * 64 * 32 * 4 <= (size_t)512 * 1024 * 1024, "d_ws map");
constexpr size_t WS_CTL = WS_END;
static_assert(WS_CTL + 65536 <= (size_t)512 * 1024 * 1024 && WS_X % 256 == 0 && WS_XN % 256 == 0 && WS_QKV % 256 == 0 && WS_MOD % 256 == 0, "d_ws map");
constexpr int LDS_TOTAL = 147456;
static_assert(attn_body::ATTN_LDS_BYTES <= pg8::STAGE_BYTES && pg8::STAGE_BYTES <= LDS_TOTAL, "LDS map");

#define LAS __attribute__((address_space(3)))
typedef unsigned short bf16;
typedef unsigned v4u __attribute__((ext_vector_type(4)));
typedef unsigned v2u __attribute__((ext_vector_type(2)));
typedef float f32x4 __attribute__((ext_vector_type(4)));
__device__ __forceinline__ unsigned f2bf(float f) { unsigned u = __builtin_bit_cast(unsigned, f); return (u + 0x7fffu + ((u >> 16) & 1u)) >> 16; }
__device__ __forceinline__ unsigned pk2(float lo, float hi) { return f2bf(lo) | (f2bf(hi) << 16); }
__device__ __forceinline__ float bflo(unsigned w) { return __builtin_bit_cast(float, w << 16); }
__device__ __forceinline__ float bfhi(unsigned w) { return __builtin_bit_cast(float, w & 0xffff0000u); }
__device__ __forceinline__ float wave_sum(float v) {
#pragma unroll
    for (int o = 1; o < 64; o <<= 1) v += __shfl_xor(v, o);
    return v;
}
struct Args {
    const float *x, *c, *ctx, *c_ctx, *ada_w, *ada_b, *w_gate, *w_up, *w_down, *par_w_in, *par_w_out, *na_rpb, *q_gain, *k_gain, *diff_w_in, *diff_w_out, *lq1, *lk1, *lq2, *lk2, *subln, *fgain;
    float* out; unsigned char* ws;
};
__device__ __forceinline__ void transpose_item(const float* W, int K, int N, bf16* WT, LAS float* scr, int k0, int n0, int wrow0, int lane) {
    float tv[32];
#pragma unroll
    for (int i = 0; i < 32; ++i) tv[i] = W[(size_t)(k0 + 2 * i + (lane >> 5)) * N + n0 + (lane & 31)];
#pragma unroll
    for (int i = 0; i < 32; ++i) scr[(2 * i + (lane >> 5)) * 33 + (lane & 31)] = tv[i];
    asm volatile("s_waitcnt lgkmcnt(0)" ::: "memory");
    const int c = lane & 7;
#pragma unroll
    for (int j = 0; j < 4; ++j) { const int n = (lane >> 3) + 8 * j; const LAS float* s = scr + (8 * c) * 33 + n;
        v4u o; o.x = pk2(s[0 * 33], s[1 * 33]); o.y = pk2(s[2 * 33], s[3 * 33]); o.z = pk2(s[4 * 33], s[5 * 33]); o.w = pk2(s[6 * 33], s[7 * 33]);
        *(v4u*)(WT + (size_t)(wrow0 + n) * K + k0 + 8 * c) = o; }
    asm volatile("s_waitcnt lgkmcnt(0)" ::: "memory");
}
__device__ __forceinline__ bool transpose_mat(int& r, const float* W, int K, int N, bf16* WT, int gu, LAS float* scr, int lane) {
    const int nblk = N / 32, cnt = (K / 64) * nblk;
    if (r >= cnt) { r -= cnt; return false; }
    const int kb = r / nblk, nb = r % nblk, n0 = 32 * nb;
    const int wrow0 = gu ? (256 * (n0 / 128) + 128 * (gu - 1) + (n0 % 128)) : n0;
    transpose_item(W, K, N, WT, scr, 64 * kb, n0, wrow0, lane); return true;
}
__device__ __forceinline__ const float* row_src(int row, const float* lat, long lat_bs, const float* cx, long ctx_bs, int& s) {
    const int b = row / TPB, t = row - b * TPB;
    if (t < CTXL) { s = 4; return cx + (size_t)b * ctx_bs + (size_t)t * DMODEL; }
    s = b; return lat + (size_t)b * lat_bs + (size_t)(t - CTXL) * DMODEL;
}
__device__ __forceinline__ void norm_mod_phase(const float* lat, long lat_bs, const float* cx, long ctx_bs, const float* modl, int shoff, int scoff, bf16* XN, int skip_ctx, int gw, int NGW, float* xcopy, const float* part, int nkc, const float* pgate) {
    int t_ = threadIdx.x; asm volatile("" : "+v"(t_)); const int lane = t_ & 63;
    for (int row = gw; row < MROWS; row += NGW) {
        int s; const float* src = row_src(row, lat, lat_bs, cx, ctx_bs, s);
        if (skip_ctx && s == 4) continue;
        const f32x4* xr = (const f32x4*)src + lane; f32x4 v[4]; float ss = 0.f;
#pragma unroll
        for (int j = 0; j < 4; ++j) { v[j] = xr[64 * j]; ss += (v[j].x * v[j].x + v[j].y * v[j].y) + (v[j].z * v[j].z + v[j].w * v[j].w); }
        if (xcopy && s == 4) {
            const int b_ = row / TPB, cr = b_ * CTXL + (row - b_ * TPB); const f32x4* gp = (const f32x4*)(pgate + 4 * NMOD6) + lane;
            f32x4 sm[4];
#pragma unroll
            for (int j = 0; j < 4; ++j) sm[j] = (f32x4){0.f, 0.f, 0.f, 0.f};
            for (int kc = 0; kc < nkc; ++kc) { const f32x4* pp = (const f32x4*)(part + ((size_t)kc * 1024 + cr) * DMODEL) + lane;
#pragma unroll
                for (int j = 0; j < 4; ++j) sm[j] += pp[64 * j]; }
            f32x4* xc = (f32x4*)(xcopy + (size_t)row * DMODEL) + lane; ss = 0.f;
#pragma unroll
            for (int j = 0; j < 4; ++j) { v[j] += gp[64 * j] * sm[j]; xc[64 * j] = v[j]; ss += (v[j].x * v[j].x + v[j].y * v[j].y) + (v[j].z * v[j].z + v[j].w * v[j].w); } }
        const float rstd = 1.0f / sqrtf(wave_sum(ss) * (1.0f / DMODEL) + EPS);
        const f32x4* sh = (const f32x4*)(modl + s * NMOD6 + shoff) + lane; const f32x4* sc = (const f32x4*)(modl + s * NMOD6 + scoff) + lane;
        v2u* o8 = (v2u*)(XN + (size_t)row * DMODEL) + lane;
#pragma unroll
        for (int j = 0; j < 4; ++j) { const f32x4 a = sh[64 * j], m = sc[64 * j]; const f32x4 y = v[j] * rstd * (m + 1.0f) + a; v2u w; w.x = pk2(y.x, y.y); w.y = pk2(y.z, y.w); o8[64 * j] = w; }
    }
}
typedef __attribute__((address_space(1))) unsigned gu32;
#define XB_TMO      128
#define XB_XCNT(j)  (256  + 64 * (j))
#define XB_XSUB(j)  (1280 + 64 * (j))
#define XB_XGEN(j)  (2304 + 64 * (j))
#define XB_TOP      3328
#define XB_TOPGEN   3392
#define XCD_BAR_WORDS 3456
#define XB_SPIN_CAP (1u << 18)

__device__ __forceinline__ unsigned xb_ld(unsigned* p)              { return __hip_atomic_load(p, __ATOMIC_RELAXED, __HIP_MEMORY_SCOPE_AGENT); }
__device__ __forceinline__ unsigned xb_add(unsigned* p, unsigned v) { return __hip_atomic_fetch_add(p, v, __ATOMIC_RELAXED, __HIP_MEMORY_SCOPE_AGENT); }
__device__ __forceinline__ unsigned xb_xcc_id() { return (unsigned)__builtin_amdgcn_s_getreg((3 << 11) | 20) & 0xFu; }
#define XB_SPIN(cond, bar) do { unsigned _sp = 0; while (cond) { __builtin_amdgcn_s_sleep(1); \
    if ((++_sp & 255u) == 0u) { if (xb_ld(&(bar)[XB_TMO])) break; if (_sp > XB_SPIN_CAP) { atomicAdd(&(bar)[XB_TMO], 1u); break; } } } } while (0)

struct XcdBarrier {
    unsigned* bar; unsigned x;
    volatile LAS unsigned* st;
};

__device__ __forceinline__ XcdBarrier xcd_barrier_post(unsigned* bar, volatile LAS unsigned* st) {
    XcdBarrier b; b.bar = bar; b.x = xb_xcc_id(); b.st = st;
    if (threadIdx.x == 0) (void)xb_add(&bar[XB_XCNT(b.x)], 1u);
    return b;
}
__device__ __forceinline__ void xcd_barrier_complete(unsigned* bar, unsigned x, unsigned& nloc, unsigned& nx) {
    const unsigned G = gridDim.x * gridDim.y * gridDim.z;
    unsigned sum, cnt, mine, sp = 0u;
    for (;;) {
        sum = 0u; cnt = 0u; mine = 0u;
#pragma unroll
        for (unsigned j = 0; j < 16; ++j) { const unsigned c = xb_ld(&bar[XB_XCNT(j)]); sum += c; cnt += (c > 0u) ? 1u : 0u; mine = (j == x) ? c : mine; }
        if (sum == G) break;
        __builtin_amdgcn_s_sleep(1);
        if ((++sp & 255u) == 0u) { if (xb_ld(&bar[XB_TMO])) break; if (sp > XB_SPIN_CAP) { atomicAdd(&bar[XB_TMO], 1u); break; } }
    }
    nloc = mine > 0u ? mine : 1u; nx = cnt > 0u ? cnt : 1u;
}

__device__ __forceinline__ void xcd_barrier(const XcdBarrier& b) {
    asm volatile("s_waitcnt vmcnt(0)" ::: "memory");
    __syncthreads();
    if (threadIdx.x == 0) {
        unsigned* bar = b.bar;
        __builtin_amdgcn_s_waitcnt(0);
        unsigned nloc = b.st[0], nx = b.st[1];
        if (nloc == 0u) { xcd_barrier_complete(bar, b.x, nloc, nx); b.st[0] = nloc; b.st[1] = nx; }
        const unsigned old = xb_add(&bar[XB_XSUB(b.x)], 1u);
        const unsigned gen = old / nloc;
        if (old + 1u == (gen + 1u) * nloc) {
            __builtin_amdgcn_fence(__ATOMIC_RELEASE, "agent");
            asm volatile("s_waitcnt vmcnt(0)" ::: "memory");
            const unsigned og = xb_add(&bar[XB_TOP], 1u);
            const unsigned tg = og / nx;
            if (og + 1u == (tg + 1u) * nx) xb_add(&bar[XB_TOPGEN], 1u);
            else XB_SPIN(xb_ld(&bar[XB_TOPGEN]) == tg, bar);
            __builtin_amdgcn_fence(__ATOMIC_ACQUIRE, "agent");
            xb_add(&bar[XB_XGEN(b.x)], 1u);
            asm volatile("s_waitcnt vmcnt(0)" ::: "memory");
        } else {
            XB_SPIN(xb_ld(&bar[XB_XGEN(b.x)]) == gen, bar);
            __builtin_amdgcn_fence(__ATOMIC_ACQUIRE, "agent");
            asm volatile("s_waitcnt vmcnt(0)" ::: "memory");
        }
    }
    __syncthreads();
}

#define FRESH_LANE() ({ int t_ = threadIdx.x; asm volatile("" : "+v"(t_)); t_ & 63; })
struct AttnDesc { const attn_body::bf16 *Q, *K, *V; attn_body::bf16* O; int PQ, PK, PV, PO, NT; };

#define W_IN(l) ((bf16*)(ws + ((l) ? WS_W_IN1 : WS_W_IN0)))
#define W_OUT(l) ((bf16*)(ws + ((l) ? WS_W_OUT1 : WS_W_OUT0)))
#define W_GU(l) ((bf16*)(ws + ((l) ? WS_W_GU1 : WS_W_GU0)))
#define W_DN(l) ((bf16*)(ws + ((l) ? WS_W_DN1 : WS_W_DN0)))
template <int l> __device__ __forceinline__ void layer_body(const Args& a, unsigned char* lds, const XcdBarrier& bar, int G, int bx, int vcu, int gw, int NGW, int lane_, int tid_k, int wave) {
    unsigned char* ws = a.ws;
    float* MOD = (float*)(ws + WS_MOD); float* ROPE = (float*)(ws + WS_ROPE); float* X = (float*)(ws + WS_X);
    bf16* XN = (bf16*)(ws + WS_XN); bf16* QKV = (bf16*)(ws + WS_QKV); bf16* HB = QKV; bf16* AO = XN; bf16* OP = (bf16*)a.out;
    LAS unsigned char* ldsl = (LAS unsigned char*)lds;
        const float* modl = MOD + (size_t)l * 5 * NMOD6;
        const int last = (l == 1);
        const float* lat = l == 0 ? a.x : X + (size_t)CTXL * DMODEL; const long lat_bs = l == 0 ? (long)SEQ * DMODEL : (long)TPB * DMODEL;
        const float* cxs = l == 0 ? a.ctx : X; const long ctx_bs = l == 0 ? (long)CTXL * DMODEL : (long)TPB * DMODEL;
        norm_mod_phase(lat, lat_bs, cxs, ctx_bs, modl, 0, DMODEL, XN, 0, gw, NGW, l == 1 ? X : nullptr, (const float*)(ws + WS_PART), 11, MOD + 5 * DMODEL);
        xcd_barrier(bar);
        {
            if constexpr (l == 0) {
                pg8::Gemm g{XN, W_IN(0), MROWS, PAR_IN, DMODEL, DMODEL}; pg8::StaticOrder S; S.init(MROWS, PAR_IN, G, bx);
                pg8::EpiBf16<0> E{QKV, PAR_IN, nullptr, 512, 512, attn_body::C2};
                pg8::gemm_phase<pg8::EpiBf16<0>, pg8::StaticOrder, PG8_ALIGN, PG8_SP2>(ldsl, g, S, E);
            } else {
                pg8::Gemm g{XN, W_IN(1), MROWS, DIFF_IN, DMODEL, DMODEL}; pg8::StaticOrder S; S.init(MROWS, DIFF_IN, G, bx);
                pg8::EpiQKVRope E{QKV, DIFF_IN, ROPE, attn_body::C2};
                pg8::gemm_phase<pg8::EpiQKVRope, pg8::StaticOrder, PG8_ALIGN, PG8_SP2>(ldsl, g, S, E);
            }
        }
        xcd_barrier(bar);
        if constexpr (l == 0) {
            const int lane = FRESH_LANE();
            for (int row = gw; row < MROWS; row += NGW) {
                const int b = row / TPB, t = row - b * TPB; const bool islat = t >= CTXL; const int pos = t - CTXL;
                unsigned* rp = (unsigned*)(QKV + (size_t)row * PAR_IN + 1536);
#pragma unroll
                for (int j = 0; j < 5; ++j) { const int p = lane + 64 * j, head = p >> 5, i = p & 31; const unsigned w = rp[p];
                    float x1 = bflo(w), x2 = bfhi(w); float ss = x1 * x1 + x2 * x2;
#pragma unroll
                    for (int o = 1; o < 32; o <<= 1) ss += __shfl_xor(ss, o);
                    const float rstd = 1.0f / sqrtf(ss * (1.0f / 64.0f) + EPS); const float* gn = head < 8 ? a.q_gain : a.k_gain;
                    x1 = x1 * rstd * gn[2 * i]; x2 = x2 * rstd * gn[2 * i + 1];
                    if (islat) { const int pp = (i < 16) ? (pos >> 6) : (pos & 63); const float cs = ROPE[(pp * 16 + (i & 15)) * 2], sn = ROPE[(pp * 16 + (i & 15)) * 2 + 1];
                        const float y1 = x1 * cs - x2 * sn, y2 = x1 * sn + x2 * cs; x1 = y1; x2 = y2; }
                    if (head < 8) { x1 *= attn_body::C2; x2 *= attn_body::C2; }
                    rp[p] = pk2(x1, x2); }
            }
            xcd_barrier(bar);
        }
        {
            typedef attn_body::bf16 abf; abf* qkv = (abf*)QKV;
            if constexpr (l == 0) {
                const int pern = (1024 + G - 1) / G;
                for (int i = 0; i < pern; ++i) { const int n = vcu * pern + i; if (n >= 1024) break;
                    const int b = n >> 8, h = (n >> 5) & 7, qb = n & 31; const int r0 = qb * 4; int nb = r0 - 4; nb = nb < 0 ? 0 : (nb > 116 ? 116 : nb);
                    const size_t rb = (size_t)b * TPB, rq = rb + CTXL + (size_t)qb * 256;
                    attn_body::attn_unit<1, 8>(qkv + rq * PAR_IN + h * 64, PAR_IN, qkv + rb * PAR_IN + 512 + h * 64, PAR_IN, qkv + rb * PAR_IN + 1024 + h * 64, PAR_IN,
                                               (abf*)AO + rq * DMODEL + h * 64, DMODEL, 16, nb, r0, (const float*)(ws + WS_MF) + (size_t)h * (15 * 2 * 64 * 16), (char*)lds); }
            }
            if constexpr (l == 0) {
                const int nun = 1024 + 64; const int per = (nun + G - 1) / G;
                for (int i = 0; i < per; ++i) {
                    AttnDesc d; bool ok = true;
                    int g; if (i < 4) g = vcu * 4 + i; else { g = 1024 + vcu; if (vcu >= 64) ok = false; }
                    if (G != 256) { g = i * G + vcu; ok = g < nun; }
                    if (ok && g < 1024) { const int bk = g >> 7, b = bk >> 1, kvh = bk & 1, rem = g & 127, head = kvh * 4 + (rem >> 5), qb = rem & 31;
                        const size_t rb = (size_t)b * TPB, rq = rb + CTXL + (size_t)qb * 256;
                        d.Q = qkv + rq * PAR_IN + 1536 + head * 64; d.K = qkv + rb * PAR_IN + 2048 + kvh * 64; d.V = qkv + rb * PAR_IN + 2176 + kvh * 64; d.O = (abf*)AO + rq * DMODEL + 512 + head * 64;
                        d.PQ = d.PK = d.PV = PAR_IN; d.PO = DMODEL; d.NT = TPB / 64; }
                    else if (ok) { const int u = g - 1024, b = u >> 4, hd = u & 15; const size_t rb = (size_t)b * TPB;
                        if (hd < 8) { d.Q = qkv + rb * PAR_IN + hd * 64; d.K = qkv + rb * PAR_IN + 512 + hd * 64; d.V = qkv + rb * PAR_IN + 1024 + hd * 64; }
                        else { const int gh = hd - 8; d.Q = qkv + rb * PAR_IN + 1536 + gh * 64; d.K = qkv + rb * PAR_IN + 2048 + (gh >> 2) * 64; d.V = qkv + rb * PAR_IN + 2176 + (gh >> 2) * 64; }
                        d.O = (abf*)AO + rb * DMODEL + hd * 64; d.PQ = d.PK = d.PV = PAR_IN; d.PO = DMODEL; d.NT = CTXL / 64; }
                    if (ok) attn_body::attn_unit<0, 8>(d.Q, d.PQ, d.K, d.PK, d.V, d.PV, d.O, d.PO, d.NT, 0, 0, nullptr, (char*)lds);
                }
            } else {
                const int nun = 2048; const int per = (nun + G - 1) / G;
                const float lam = expf(wave_sum(a.lq1[FRESH_LANE()] * a.lk1[FRESH_LANE()])) - expf(wave_sum(a.lq2[FRESH_LANE()] * a.lk2[FRESH_LANE()])) + LAMBDA_INIT;
                for (int i = 0; i < per; ++i) {
                    int g; bool ok = true; if (G == 256) g = (((vcu >> 5) * 4 + (i >> 1)) << 6) + (i & 1) * 32 + (vcu & 31); else { g = i * G + vcu; ok = g < nun; }
                    if (ok) { const int bh = g >> 6, b = bh >> 3, h = bh & 7, sub = g & 63, map = sub >> 5, qb = sub & 31;
                        const size_t rb = (size_t)b * TPB, rq = rb + CTXL + (size_t)qb * 256;
                        attn_body::attn_unit<2, 8>(qkv + rq * DIFF_IN + h * 128 + map * 64, DIFF_IN, qkv + rb * DIFF_IN + 1024 + h * 128 + map * 64, DIFF_IN, qkv + rb * DIFF_IN + 2048 + h * 128, DIFF_IN,
                                                   (abf*)OP + ((size_t)b * SEQ + (size_t)qb * 256) * 2048 + map * 1024 + h * 128, 2048, TPB / 64, 0, 0, nullptr, (char*)lds);
                        if (G == 256 && map == 1) {
                            asm volatile("s_waitcnt vmcnt(0)" ::: "memory"); __builtin_amdgcn_fence(__ATOMIC_SEQ_CST, "workgroup");
                            const int lane = FRESH_LANE(), rsub = lane >> 3, ch = lane & 7;
                            const f32x4* gp = (const f32x4*)(a.subln + ch * 16); const f32x4 g0 = gp[0], g1 = gp[1], g2 = gp[2], g3 = gp[3];
                            const float gn[16] = {g0.x, g0.y, g0.z, g0.w, g1.x, g1.y, g1.z, g1.w, g2.x, g2.y, g2.z, g2.w, g3.x, g3.y, g3.z, g3.w};
#pragma unroll
                            for (int it = 0; it < 4; ++it) { const int r = wave * 32 + it * 8 + rsub; const size_t lr = (size_t)b * SEQ + (size_t)qb * 256 + r;
                                const v4u* p1 = (const v4u*)(OP + lr * 2048 + h * 128) + ch * 2; const v4u* p2 = (const v4u*)(OP + lr * 2048 + 1024 + h * 128) + ch * 2;
                                const v4u a0 = p1[0], a1 = p1[1], b0 = p2[0], b1 = p2[1];
                                const unsigned wa[8] = {a0.x, a0.y, a0.z, a0.w, a1.x, a1.y, a1.z, a1.w}, wb[8] = {b0.x, b0.y, b0.z, b0.w, b1.x, b1.y, b1.z, b1.w};
                                float o[16]; float ss = 0.f;
#pragma unroll
                                for (int e = 0; e < 8; ++e) { o[2 * e] = bflo(wa[e]) - lam * bflo(wb[e]); o[2 * e + 1] = bfhi(wa[e]) - lam * bfhi(wb[e]); ss += o[2 * e] * o[2 * e] + o[2 * e + 1] * o[2 * e + 1]; }
                                ss += __shfl_xor(ss, 1); ss += __shfl_xor(ss, 2); ss += __shfl_xor(ss, 4);
                                const float rs = (1.0f - LAMBDA_INIT) / sqrtf(ss * (1.0f / 128.0f) + EPS);
                                unsigned w[8];
#pragma unroll
                                for (int e = 0; e < 8; ++e) w[e] = pk2(o[2 * e] * rs * gn[2 * e], o[2 * e + 1] * rs * gn[2 * e + 1]);
                                v4u* op = (v4u*)(AO + (rq + r) * DMODEL + h * 128) + ch * 2; op[0] = (v4u){w[0], w[1], w[2], w[3]}; op[1] = (v4u){w[4], w[5], w[6], w[7]}; }
                        }
                    }
                }
            }
        }
        xcd_barrier(bar);
        if (l == 1 && G != 256) {
            const int lane = FRESH_LANE();
            const float d1 = wave_sum(a.lq1[lane] * a.lk1[lane]), d2 = wave_sum(a.lq2[lane] * a.lk2[lane]);
            const float lam = expf(d1) - expf(d2) + LAMBDA_INIT;
            const f32x4* gp = (const f32x4*)(a.subln + (lane & 7) * 16); const f32x4 g0 = gp[0], g1 = gp[1], g2 = gp[2], g3 = gp[3];
            const float gn[16] = {g0.x, g0.y, g0.z, g0.w, g1.x, g1.y, g1.z, g1.w, g2.x, g2.y, g2.z, g2.w, g3.x, g3.y, g3.z, g3.w};
            for (int lr = gw; lr < NBATCH * SEQ; lr += NGW) {
                const int b = lr / SEQ, pos = lr - b * SEQ; const size_t row = (size_t)b * TPB + CTXL + pos;
                const v4u* p1 = (const v4u*)(OP + (size_t)lr * 2048) + lane * 2; const v4u* p2 = p1 + 128;
                const v4u a0 = p1[0], a1 = p1[1], b0 = p2[0], b1 = p2[1];
                const unsigned wa[8] = {a0.x, a0.y, a0.z, a0.w, a1.x, a1.y, a1.z, a1.w}, wb[8] = {b0.x, b0.y, b0.z, b0.w, b1.x, b1.y, b1.z, b1.w};
                float o[16]; float ss = 0.f;
#pragma unroll
                for (int e = 0; e < 8; ++e) { o[2 * e] = bflo(wa[e]) - lam * bflo(wb[e]); o[2 * e + 1] = bfhi(wa[e]) - lam * bfhi(wb[e]); ss += o[2 * e] * o[2 * e] + o[2 * e + 1] * o[2 * e + 1]; }
                ss += __shfl_xor(ss, 1); ss += __shfl_xor(ss, 2); ss += __shfl_xor(ss, 4);
                const float rs = (1.0f - LAMBDA_INIT) / sqrtf(ss * (1.0f / 128.0f) + EPS);
                unsigned w[8];
#pragma unroll
                for (int e = 0; e < 8; ++e) w[e] = pk2(o[2 * e] * rs * gn[2 * e], o[2 * e + 1] * rs * gn[2 * e + 1]);
                v4u* op = (v4u*)(AO + row * DMODEL) + lane * 2; op[0] = (v4u){w[0], w[1], w[2], w[3]}; op[1] = (v4u){w[4], w[5], w[6], w[7]};
            }
            xcd_barrier(bar);
        }
        {
            pg8::Gemm g{AO, W_OUT(l), MROWS, DMODEL, DMODEL, DMODEL}; pg8::StaticOrder S; S.init(MROWS, DMODEL, G, bx, 1);
            pg8::EpiRes E{lat, lat_bs, cxs, ctx_bs, X, modl + 2 * DMODEL};
            pg8::gemm_phase<pg8::EpiRes, pg8::StaticOrder, PG8_ALIGN, PG8_SP2>(ldsl, g, S, E);
            if constexpr (l == 0) {
                pg8::Gemm gc{AO, W_OUT(0), MROWS, DMODEL, 256, DMODEL}; pg8::CtxSplitOrder Sc; Sc.init(4, G, bx);
                pg8::EpiPartial Ec{(float*)(ws + WS_PART)};
                pg8::gemm_phase<pg8::EpiPartial, pg8::CtxSplitOrder, PG8_ALIGN, PG8_SP2>(ldsl, gc, Sc, Ec);
            }
        }
        xcd_barrier(bar);
        norm_mod_phase(X + (size_t)CTXL * DMODEL, (long)TPB * DMODEL, l == 0 ? a.ctx : X, l == 0 ? (long)CTXL * DMODEL : (long)TPB * DMODEL, modl, 3 * DMODEL, 4 * DMODEL, XN, last, gw, NGW, l == 0 ? X : nullptr, (const float*)(ws + WS_PART), 4, modl + 2 * DMODEL);
        xcd_barrier(bar);
        {
            pg8::Gemm g{XN, W_GU(l), MROWS, 2 * DFF, DMODEL, DMODEL}; pg8::StaticOrder S; S.init(MROWS, 2 * DFF, G, bx, last);
            pg8::EpiSwiGLU E{HB, DFF};
            pg8::gemm_phase<pg8::EpiSwiGLU, pg8::StaticOrder, PG8_ALIGN, PG8_SP2>(ldsl, g, S, E);
        }
        xcd_barrier(bar);
        {
            pg8::Gemm g{HB, W_DN(l), MROWS, DMODEL, DFF, DFF}; pg8::StaticOrder S; S.init(MROWS, DMODEL, G, bx, 1);
            pg8::EpiRes E{X + (size_t)CTXL * DMODEL, (long)TPB * DMODEL, X, (long)TPB * DMODEL, X, modl + 5 * DMODEL};
            pg8::gemm_phase<pg8::EpiRes, pg8::StaticOrder, PG8_ALIGN, PG8_SP2>(ldsl, g, S, E);
            if constexpr (l == 0) {
                pg8::Gemm gc{HB, W_DN(0), MROWS, DMODEL, 256, DFF}; pg8::CtxSplitOrder Sc; Sc.init(11, G, bx);
                pg8::EpiPartial Ec{(float*)(ws + WS_PART)};
                pg8::gemm_phase<pg8::EpiPartial, pg8::CtxSplitOrder, PG8_ALIGN, PG8_SP2>(ldsl, gc, Sc, Ec);
            }
        }
        xcd_barrier(bar);
    }

__global__ void __launch_bounds__(NTHREADS, 2) fwd_megakernel(Args a) {
    __shared__ __attribute__((aligned(16))) unsigned char lds[LDS_TOTAL];
    cg::grid_group grid = cg::this_grid();
    const int tid = threadIdx.x, lane = tid & 63, wave = __builtin_amdgcn_readfirstlane(tid >> 6);
    const int G = gridDim.x, bx = blockIdx.x;
    const int vcu = (G % 8 == 0) ? (bx % 8) * (G / 8) + bx / 8 : bx;
    const int gw = vcu * NWAVES + wave, NGW = G * NWAVES;
    unsigned char* ws = a.ws;
    float* MOD = (float*)(ws + WS_MOD); float* ROPE = (float*)(ws + WS_ROPE); float* X = (float*)(ws + WS_X);
    bf16* XN = (bf16*)(ws + WS_XN); bf16* QKV = (bf16*)(ws + WS_QKV); bf16* HB = QKV; bf16* AO = XN; bf16* OP = (bf16*)a.out;
    LAS unsigned char* ldsl = (LAS unsigned char*)lds;

    volatile LAS unsigned* bst = (volatile LAS unsigned*)(ldsl + 131072 + 512);
    if (tid < 2) bst[tid] = 0u;
    unsigned* barw = (unsigned*)(ws + WS_CTL);
    if (bx == 0) for (int i = tid; i < XCD_BAR_WORDS; i += NTHREADS) barw[i] = 0u;
    {
        for (int it = bx; it < 192; it += G) {
            LAS float* sl = (LAS float*)ldsl;
            LAS float* part = sl + 5 * 1024;
            for (int i = tid; i < 5 * 1024; i += NTHREADS) { const float cv = (i < 4096) ? a.c[i] : a.c_ctx[i - 4096]; sl[i] = cv / (1.0f + __expf(-cv)); }
            __syncthreads();
            const int l = it / 96, n = (it % 96) * 64 + lane; const float* wp = a.ada_w + (size_t)l * DMODEL * NMOD6 + n;
            float acc[5] = {0.f, 0.f, 0.f, 0.f, 0.f};
#pragma unroll 32
            for (int k = wave * 128; k < wave * 128 + 128; ++k) { const float w = wp[(size_t)k * NMOD6];
#pragma unroll
                for (int s = 0; s < 5; ++s) acc[s] += sl[s * 1024 + k] * w; }
#pragma unroll
            for (int s = 0; s < 5; ++s) part[(wave * 5 + s) * 64 + lane] = acc[s];
            __syncthreads();
            if (tid < 320) { const int s = tid / 64, ln = tid % 64; float t = a.ada_b[l * NMOD6 + (it % 96) * 64 + ln];
#pragma unroll
                for (int w = 0; w < 8; ++w) t += part[(w * 5 + s) * 64 + ln];
                MOD[(size_t)(l * 5 + s) * NMOD6 + (it % 96) * 64 + ln] = t; }
            __syncthreads();
        }
        {
            unsigned* MF = (unsigned*)(ws + WS_MF);
            for (int idx = bx * NTHREADS + tid; idx < 8 * 15 * 2 * 64 * 16; idx += G * NTHREADS) {
                const int w = idx & 15, ln = (idx >> 4) & 63, chalf = (idx >> 10) & 1, rest = idx >> 11, dr = rest % 15, h = rest / 15;
                const int hi = ln >> 5, c = chalf * 32 + (ln & 31); int cs = c - 8; cs = cs < 0 ? 0 : (cs > 48 ? 48 : cs);
                unsigned pr[2];
#pragma unroll
                for (int q = 0; q < 2; ++q) { const int e = 2 * w + q, ee = e & 15, j = (ee & 3) + 8 * (ee >> 2) + 4 * hi + (e >= 16 ? 32 : 0);
                    pr[q] = (j >= cs && j < cs + 16) ? f2bf(a.na_rpb[h * 465 + dr * 31 + (j - c + 15)] * 1.4426950408889634f) : 0xff80u; }
                MF[idx] = pr[0] | (pr[1] << 16);
            }
        }
        if (bx == G - 1) {
            for (int i = tid; i < 128 * 16; i += NTHREADS) { const int pos = i / 16, f = i % 16; const float inv = powf(10000.0f, -(float)f / 16.0f); const float ang = (float)pos * inv;
                ROPE[2 * i] = cosf(ang); ROPE[2 * i + 1] = sinf(ang); }
        }
        __syncthreads();
        LAS float* scr = (LAS float*)(ldsl + wave * 16384);
        constexpr int NITEMS = 16 * (PAR_IN / 32) + 16 * (DIFF_IN / 32) + 2 * (16 * 32 + 2 * 16 * (DFF / 32) + (DFF / 64) * 32);
        for (int it = gw; it < NITEMS; it += NGW) {
            int r = it;
            if (transpose_mat(r, a.par_w_in, DMODEL, PAR_IN, W_IN(0), 0, scr, lane)) continue;
            if (transpose_mat(r, a.par_w_out, DMODEL, DMODEL, W_OUT(0), 0, scr, lane)) continue;
            if (transpose_mat(r, a.w_gate, DMODEL, DFF, W_GU(0), 1, scr, lane)) continue;
            if (transpose_mat(r, a.w_up, DMODEL, DFF, W_GU(0), 2, scr, lane)) continue;
            if (transpose_mat(r, a.w_down, DFF, DMODEL, W_DN(0), 0, scr, lane)) continue;
            if (transpose_mat(r, a.diff_w_in, DMODEL, DIFF_IN, W_IN(1), 0, scr, lane)) continue;
            if (transpose_mat(r, a.diff_w_out, DMODEL, DMODEL, W_OUT(1), 0, scr, lane)) continue;
            if (transpose_mat(r, a.w_gate + (size_t)DMODEL * DFF, DMODEL, DFF, W_GU(1), 1, scr, lane)) continue;
            if (transpose_mat(r, a.w_up + (size_t)DMODEL * DFF, DMODEL, DFF, W_GU(1), 2, scr, lane)) continue;
            transpose_mat(r, a.w_down + (size_t)DFF * DMODEL, DFF, DMODEL, W_DN(1), 0, scr, lane);
        }
    }
    grid.sync();
    const XcdBarrier bar = xcd_barrier_post(barw, bst);

    layer_body<0>(a, lds, bar, G, bx, vcu, gw, NGW, lane, tid, wave);
    layer_body<1>(a, lds, bar, G, bx, vcu, gw, NGW, lane, tid, wave);
    { const int lane = FRESH_LANE();
    for (int lr = gw; lr < NBATCH * SEQ; lr += NGW) {
        const int b = lr / SEQ, pos = lr - b * SEQ; const f32x4* xr = (const f32x4*)(X + ((size_t)b * TPB + CTXL + pos) * DMODEL) + lane; f32x4 v[4]; float ss = 0.f;
#pragma unroll
        for (int j = 0; j < 4; ++j) { v[j] = xr[64 * j]; ss += (v[j].x * v[j].x + v[j].y * v[j].y) + (v[j].z * v[j].z + v[j].w * v[j].w); }
        const float rstd = 1.0f / sqrtf(wave_sum(ss) * (1.0f / DMODEL) + EPS);
        const f32x4* gp = (const f32x4*)a.fgain + lane; f32x4* op = (f32x4*)(a.out + (size_t)lr * DMODEL) + lane;
#pragma unroll
        for (int j = 0; j < 4; ++j) op[64 * j] = v[j] * rstd * gp[64 * j];
    } }
}

extern "C" void kernel_launch(void* const* d_in, const int* in_sizes, int n_in, void* d_out, int out_size, void* d_ws, size_t ws_size, hipStream_t stream) {
    static int grid = 0;
    if (grid == 0) {
        if (n_in != 22 || in_sizes[0] != NBATCH * SEQ * DMODEL || out_size != NBATCH * SEQ * DMODEL || ws_size < WS_MF + (size_t)8 * 15 * 2 * 64 * 16 * 4) { fprintf(stderr, "kernel_launch: unexpected problem shape (n_in %d, ws %zu)\n", n_in, ws_size); grid = -1; return; }
        int dev = 0, cus = 0, per_cu = 0;
        hipGetDevice(&dev); hipDeviceGetAttribute(&cus, hipDeviceAttributeMultiprocessorCount, dev);
        hipOccupancyMaxActiveBlocksPerMultiprocessor(&per_cu, (const void*)fwd_megakernel, NTHREADS, 0);
        if (per_cu < 1) { fprintf(stderr, "kernel_launch: occupancy query says %d blocks per CU\n", per_cu); per_cu = 1; }
        (void)hipGetLastError();
        grid = cus;
    }
    if (grid < 0) return;
    Args a{};
    const float** ap = (const float**)&a;
    for (int i = 0; i < 22; ++i) ap[i] = (const float*)d_in[i];
    a.out = (float*)d_out; a.ws = (unsigned char*)d_ws;
    void* args[] = {&a};
    hipError_t e = hipLaunchCooperativeKernel((const void*)fwd_megakernel, dim3(grid), dim3(NTHREADS), args, 0, stream);
    if (e != hipSuccess) fprintf(stderr, "cooperative launch failed: %s (grid %d)\n", hipGetErrorString(e), grid);
}
```

```cpp
#include <hip/hip_runtime.h>
#include <hip/hip_cooperative_groups.h>
#include <cstdio>
#include <cstdint>
namespace cg = cooperative_groups;
namespace pg8 {
#define PG8_LAS __attribute__((address_space(3)))
typedef unsigned short bf16_t;
typedef short bf16x8 __attribute__((ext_vector_type(8)));
typedef float f32x4 __attribute__((ext_vector_type(4)));
typedef unsigned u32x4 __attribute__((ext_vector_type(4)));
constexpr int BM = 256, BK = 64, HALF = 128, HTB = HALF * BK * 2  , STAGE_BYTES = 8 * HTB, NXCD = 8, WGM = 8;

__host__ __device__ __forceinline__ int lds_byte(int r, int c) { const int st = (r >> 4) * 2 + (c >> 5), rr = r & 15, cc = c & 31, ob = rr * 64 + cc * 2; return st * 1024 + (ob ^ (((ob >> 9) & 1) << 5)); }
__host__ __device__ __forceinline__ void stage_rc(int b, int& R, int& C) { const int st = b / 1024, sb = b % 1024, swz = sb ^ (((sb >> 9) & 1) << 5); R = (st >> 1) * 16 + swz / 64; C = (st & 1) * 32 + (swz % 64) / 2; }
__host__ __device__ __forceinline__ int perm32(int rho) { const int n = rho >> 4, i = rho & 15; return 8 * (i >> 2) + 4 * n + (i & 3); }

struct Unit { int pm, pn, kc; };
struct Gemm { const bf16_t* A; const bf16_t* Bt; int M, N, K, ld; };

struct StaticOrder {
    static constexpr bool OPAQUE_NT = false;
    int nM, nN, nwg, G, c, skip;
    __host__ __device__ void init(int M, int N, int G_, int c_, int skip_ = 0) { skip = skip_; nM = skip ? 128 : M / BM; nN = N / BM; nwg = nM * nN; G = G_; c = c_; }
    __host__ __device__ bool next(int i, Unit& u) const {
        const long L = (long)i * G + c; if (L >= nwg) return false;
        int wgid = (int)L; { const int q = nwg / NXCD, r = nwg % NXCD, xcd = wgid % NXCD, off = wgid / NXCD; wgid = (xcd < r ? xcd * (q + 1) : r * (q + 1) + (xcd - r) * q) + off; }
        const int nig = WGM * nN, gid = wgid / nig, fm = gid * WGM, gsz = (nM - fm) < WGM ? (nM - fm) : WGM;
        u.pm = fm + ((wgid % nig) % gsz); u.pn = (wgid % nig) / gsz; u.kc = 0; if (skip) u.pm += u.pm / 32 + 1; return true;
    }
    __device__ __forceinline__ void a_ready(const Unit&) const {}
    __device__ __forceinline__ void done(const Unit&) const {}
};

struct CtxSplitOrder {
    static constexpr bool OPAQUE_NT = true;
    int nkc, G, c;
    __host__ __device__ void init(int nkc_, int G_, int c_) { nkc = nkc_; G = G_; c = c_; }
    __host__ __device__ bool next(int i, Unit& u) const { const int L = i * G + c; if (L >= 16 * nkc) return false; u.kc = L % nkc; const int t = L / nkc; u.pn = t & 3; u.pm = 33 * (t >> 2); return true; }
    __device__ __forceinline__ void a_ready(const Unit&) const {}
    __device__ __forceinline__ void done(const Unit&) const {}
};
__device__ __forceinline__ unsigned cvt_pk_bf16(float lo, float hi) { unsigned r; asm volatile("v_cvt_pk_bf16_f32 %0, %1, %2" : "=v"(r) : "v"(lo), "v"(hi)); return r; }
typedef float f32x2 __attribute__((ext_vector_type(2)));
__device__ __forceinline__ f32x2 gelu_pk(f32x2 v) {
    const f32x2 av = __builtin_elementwise_abs(v), d = av * 0.2316418882f + 1.0f;
    f32x2 t; t.x = __builtin_amdgcn_rcpf(d.x); t.y = __builtin_amdgcn_rcpf(d.y);
    f32x2 q = t * 0.5307027145f + (-0.7265760135f); q = q * t + 0.7107068705f; q = q * t + (-0.142248368f); q = q * t + 0.127414796f; q = q * t;
    const f32x2 s = (v * v) * (-0.72134752044f);
    f32x2 e; e.x = __builtin_amdgcn_exp2f(s.x); e.y = __builtin_amdgcn_exp2f(s.y);
    const f32x2 m = v * (q * e), r = v - m;
    f32x2 o; o.x = v.x < 0.f ? m.x : r.x; o.y = v.y < 0.f ? m.y : r.y; return o;
}

template <int ACT  > struct EpiBf16 {
    static constexpr bool PERM = true, AFTER_DRAIN = false; static_assert(ACT == 0 || ACT == 1, "EpiBf16: ACT is 0 (none) or 1 (gelu_pk)");
    bf16_t* O; int ldc; const float* bias; int split_cols; size_t split_stride; float scale0;
    __device__ __forceinline__ void operator()(const f32x4 (&acc)[2][2][4][2], const Unit& u, int wr, int wc, int fr, int fq) const {
        const int row0 = u.pm * BM + wr * 64 + fr; int colt = u.pn * BM; bf16_t* base = O;
        float sc = 1.f; if (split_cols) { const int t = colt / split_cols; base += (size_t)t * split_stride; colt -= t * split_cols; if (t == 0) sc = scale0; }
        const int col0 = colt + wc * 32 + 8 * fq, bcol0 = u.pn * BM + wc * 32 + 8 * fq;
        f32x4 bv[2][2];
#pragma unroll
        for (int bj = 0; bj < 2; ++bj)
#pragma unroll
            for (int n = 0; n < 2; ++n) bv[bj][n] = bias ? *(const f32x4*)(bias + bcol0 + bj * HALF + 4 * n) : (f32x4){0.f, 0.f, 0.f, 0.f};
#pragma unroll
        for (int ai = 0; ai < 2; ++ai)
#pragma unroll
            for (int m = 0; m < 4; ++m) { bf16_t* rowp = base + (size_t)(row0 + ai * HALF + m * 16) * ldc + col0;
#pragma unroll
                for (int bj = 0; bj < 2; ++bj) { f32x4 v0 = acc[ai][bj][m][0] + bv[bj][0], v1 = acc[ai][bj][m][1] + bv[bj][1];
                    if (ACT == 1) { f32x2 a = gelu_pk((f32x2){v0[0], v0[1]}), b = gelu_pk((f32x2){v0[2], v0[3]}), c = gelu_pk((f32x2){v1[0], v1[1]}), d = gelu_pk((f32x2){v1[2], v1[3]});
                        v0 = (f32x4){a.x, a.y, b.x, b.y}; v1 = (f32x4){c.x, c.y, d.x, d.y}; }
                    v0 = v0 * sc; v1 = v1 * sc; u32x4 w; w.x = cvt_pk_bf16(v0[0], v0[1]); w.y = cvt_pk_bf16(v0[2], v0[3]); w.z = cvt_pk_bf16(v1[0], v1[1]); w.w = cvt_pk_bf16(v1[2], v1[3]);
                    *(u32x4*)(rowp + bj * HALF) = w; } }
    }
};
struct EpiRes {
    static constexpr bool PERM = false, AFTER_DRAIN = false;
    const float* base_lat; long lat_bs; const float* base_ctx; long ctx_bs; float* out; const float* gate;
    __device__ __forceinline__ void operator()(const f32x4 (&acc)[2][2][4][2], const Unit& u, int wr, int wc, int fr, int fq) const {
        const int b = u.pm / 33, tt = u.pm - b * 33; const bool isctx = (tt == 0);
        const float* g = gate + (isctx ? 4 : b) * 6144;
        const float* src = isctx ? base_ctx + (size_t)b * ctx_bs : base_lat + (size_t)b * lat_bs + (size_t)(tt * 256 - 256) * 1024;
        float* dst = out + (size_t)u.pm * 256 * 1024;
        const int col0 = u.pn * BM + wc * 32 + 4 * fq;
        const size_t off0 = (size_t)(wr * 64 + fr) * 1024 + col0;
#pragma unroll
        for (int bj = 0; bj < 2; ++bj)
#pragma unroll
            for (int n = 0; n < 2; ++n) { const f32x4 gv = *(const f32x4*)(g + col0 + bj * HALF + n * 16); f32x4 bs[2][4];
#pragma unroll
                for (int ai = 0; ai < 2; ++ai)
#pragma unroll
                    for (int m = 0; m < 4; ++m) bs[ai][m] = *(const f32x4*)(src + off0 + (size_t)(ai * HALF + m * 16) * 1024 + bj * HALF + n * 16);
#pragma unroll
                for (int ai = 0; ai < 2; ++ai)
#pragma unroll
                    for (int m = 0; m < 4; ++m) *(f32x4*)(dst + off0 + (size_t)(ai * HALF + m * 16) * 1024 + bj * HALF + n * 16) = bs[ai][m] + gv * acc[ai][bj][m][n];
                asm volatile("" ::: "memory"); }
    }
};
struct EpiSwiGLU {
    static constexpr bool PERM = true, AFTER_DRAIN = false;
    bf16_t* H; int ldh;
    __device__ __forceinline__ void operator()(const f32x4 (&acc)[2][2][4][2], const Unit& u, int wr, int wc, int fr, int fq) const {
        const int row0 = u.pm * BM + wr * 64 + fr, col0 = u.pn * HALF + wc * 32 + 8 * fq;
#pragma unroll
        for (int ai = 0; ai < 2; ++ai)
#pragma unroll
            for (int m = 0; m < 4; ++m) { bf16_t* rowp = H + (size_t)(row0 + ai * HALF + m * 16) * ldh + col0; float hv[8];
#pragma unroll
                for (int n = 0; n < 2; ++n)
#pragma unroll
                    for (int e = 0; e < 4; ++e) { const float g = acc[ai][0][m][n][e], up = acc[ai][1][m][n][e]; hv[n * 4 + e] = g * __builtin_amdgcn_rcpf(1.0f + __expf(-g)) * up; }
                u32x4 w; w.x = cvt_pk_bf16(hv[0], hv[1]); w.y = cvt_pk_bf16(hv[2], hv[3]); w.z = cvt_pk_bf16(hv[4], hv[5]); w.w = cvt_pk_bf16(hv[6], hv[7]);
                *(u32x4*)rowp = w; }
    }
};
struct EpiQKVRope {
    static constexpr bool PERM = true, AFTER_DRAIN = false;
    bf16_t* O; int ldc; const float* rope; float qscale;
    __device__ __forceinline__ void operator()(const f32x4 (&acc)[2][2][4][2], const Unit& u, int wr, int wc, int fr, int fq) const {
        const int b = u.pm / 33, tt = u.pm - b * 33; const bool dorope = (tt != 0) && (u.pn < 8); const float sc = (u.pn < 4) ? qscale : 1.0f;
        const int rl = wr * 64 + fr, col0 = u.pn * BM + wc * 32 + 8 * fq, i0 = (wc & 1) * 16 + 4 * fq;
#pragma unroll
        for (int ai = 0; ai < 2; ++ai)
#pragma unroll
            for (int m = 0; m < 4; ++m) { const int r = rl + ai * HALF + m * 16; bf16_t* rowp = O + (size_t)(u.pm * BM + r) * ldc + col0;
                f32x4 t0 = (f32x4){1.f, 0.f, 1.f, 0.f}, t1 = t0;
                if (dorope) { const int pos = tt * 256 - 256 + r; const int pp = (i0 < 16) ? (pos >> 6) : (pos & 63); const f32x4* tb = (const f32x4*)(rope + (pp * 16 + (i0 & 15)) * 2); t0 = tb[0]; t1 = tb[1]; }
#pragma unroll
                for (int bj = 0; bj < 2; ++bj) { const f32x4 v0 = acc[ai][bj][m][0], v1 = acc[ai][bj][m][1]; u32x4 w;
                    w.x = cvt_pk_bf16((v0[0] * t0[0] - v0[1] * t0[1]) * sc, (v0[0] * t0[1] + v0[1] * t0[0]) * sc);
                    w.y = cvt_pk_bf16((v0[2] * t0[2] - v0[3] * t0[3]) * sc, (v0[2] * t0[3] + v0[3] * t0[2]) * sc);
                    w.z = cvt_pk_bf16((v1[0] * t1[0] - v1[1] * t1[1]) * sc, (v1[0] * t1[1] + v1[1] * t1[0]) * sc);
                    w.w = cvt_pk_bf16((v1[2] * t1[2] - v1[3] * t1[3]) * sc, (v1[2] * t1[3] + v1[3] * t1[2]) * sc);
                    *(u32x4*)(rowp + bj * HALF) = w; } }
    }
};
struct EpiPartial {
    static constexpr bool PERM = false, AFTER_DRAIN = false;
    float* P;
    __device__ __forceinline__ void operator()(const f32x4 (&acc)[2][2][4][2], const Unit& u, int wr, int wc, int fr, int fq) const {
        const int col0 = u.pn * BM + wc * 32 + 4 * fq;
        float* dst = P + ((size_t)u.kc * 1024 + (u.pm / 33) * 256 + wr * 64 + fr) * 1024 + col0;
#pragma unroll
        for (int ai = 0; ai < 2; ++ai)
#pragma unroll
            for (int m = 0; m < 4; ++m) { float* p = dst + (size_t)(ai * HALF + m * 16) * 1024;
#pragma unroll
                for (int bj = 0; bj < 2; ++bj)
#pragma unroll
                    for (int n = 0; n < 2; ++n) *(f32x4*)(p + bj * HALF + n * 16) = acc[ai][bj][m][n];
                asm volatile("" ::: "memory"); }
    }
};
template <class Epi, class Sched, bool ALIGN_EPI = false, bool SP2 = false>
__device__ __forceinline__ void gemm_phase(PG8_LAS unsigned char* lds, const Gemm g, const Sched& S, const Epi& E) {
    int tid_ = threadIdx.x; asm volatile("" : "+v"(tid_));
    const int tid = tid_, wid = __builtin_amdgcn_readfirstlane(tid >> 6), lane = tid & 63, wr = wid >> 2, wc = wid & 3, fr = lane & 15, fq = lane >> 4;
    const int K = g.K, ld = g.ld; int nt_ = K / BK; if constexpr (Sched::OPAQUE_NT) asm volatile("" : "+s"(nt_));
    const int nt = nt_;
    unsigned voffA[2], voffB[2];
#pragma unroll
    for (int i = 0; i < 2; ++i) { int R, C; stage_rc(tid * 16 + i * 8192, R, C); const int Rb = Epi::PERM ? ((R & ~31) + perm32(R & 31)) : R;
        voffA[i] = (unsigned)(R * ld + C) * 2u; voffB[i] = (unsigned)(Rb * ld + C) * 2u; }
    const size_t kstep = (size_t)(BK * 2);
    const size_t hstep = (size_t)HALF * ld * 2;
    const size_t tstep = 2 * hstep;
    const unsigned ldsw = (unsigned)wid * 1024u;
    const int aoff = lds_byte(wr * 64 + fr, fq * 8), boff = lds_byte(wc * 32 + fr, fq * 8);
#define PG8_SA(b, h) (((b) * 2 + (h)) * HTB)
#define PG8_SB(b, h) ((4 + (b) * 2 + (h)) * HTB)
#define PG8_STAGE(bufoff, gbase, voff) do { _Pragma("unroll") for (int _i = 0; _i < 2; ++_i) \
        __builtin_amdgcn_global_load_lds((const unsigned*)((const char*)(gbase) + (voff)[_i]), (PG8_LAS unsigned*)(lds + (bufoff) + ldsw + _i * 8192), 16, 0, 0); } while (0)
#define PG8_LDA(dst, b, h) do { _Pragma("unroll") for (int m = 0; m < 4; ++m) _Pragma("unroll") for (int k = 0; k < 2; ++k) dst[m][k] = *(const PG8_LAS bf16x8*)(lds + PG8_SA(b, h) + aoff + m * 2048 + k * 1024); } while (0)
#define PG8_LDB(dst, b, h) do { _Pragma("unroll") for (int n = 0; n < 2; ++n) _Pragma("unroll") for (int k = 0; k < 2; ++k) dst[n][k] = *(const PG8_LAS bf16x8*)(lds + PG8_SB(b, h) + boff + n * 2048 + k * 1024); } while (0)
#define PG8_MMA(ai, bj, At, Bt) do { __builtin_amdgcn_s_setprio(1); _Pragma("unroll") for (int m = 0; m < 4; ++m) _Pragma("unroll") for (int n = 0; n < 2; ++n) _Pragma("unroll") for (int k = 0; k < 2; ++k) \
        acc[ai][bj][m][n] = __builtin_amdgcn_mfma_f32_16x16x32_bf16(Bt[n][k], At[m][k], acc[ai][bj][m][n], 0, 0, 0); __builtin_amdgcn_s_setprio(0); } while (0)
#define PG8_WAIT_V(n) asm volatile("s_waitcnt vmcnt(" #n ")" ::: "memory")
#define PG8_WAIT_L(n) asm volatile("s_waitcnt lgkmcnt(" #n ")" ::: "memory")
#define PG8_BAR __builtin_amdgcn_s_barrier()
#define PG8_SCHED __builtin_amdgcn_sched_barrier(0)
    Unit cur, nxt; int ui = 0;
    if (!S.next(0, cur)) return;
    f32x4 acc[2][2][4][2];
#pragma unroll
    for (int a = 0; a < 2; ++a)
#pragma unroll
        for (int b = 0; b < 2; ++b)
#pragma unroll
            for (int m = 0; m < 4; ++m)
#pragma unroll
                for (int n = 0; n < 2; ++n) acc[a][b][m][n] = (f32x4){0.f, 0.f, 0.f, 0.f};
    bf16x8 At[4][2], B0[2][2], B1[2][2];
    const size_t cstep = (size_t)K * 2;
    const char* cA = (const char*)g.A + (size_t)cur.pm * tstep + (size_t)cur.kc * cstep; const char* cB = (const char*)g.Bt + (size_t)cur.pn * tstep + (size_t)cur.kc * cstep;
    S.a_ready(cur);
    if constexpr (SP2) {
        PG8_STAGE(PG8_SB(0, 0), cB, voffB); PG8_STAGE(PG8_SB(0, 1), cB + hstep, voffB); PG8_STAGE(PG8_SA(0, 0), cA, voffA); PG8_STAGE(PG8_SA(0, 1), cA + hstep, voffA);
        if (wr == 1) PG8_BAR;
        PG8_WAIT_V(2); PG8_BAR;
        PG8_STAGE(PG8_SB(1, 0), cB + kstep, voffB); PG8_STAGE(PG8_SA(1, 0), cA + kstep, voffA); PG8_STAGE(PG8_SB(1, 1), cB + hstep + kstep, voffB);
        PG8_WAIT_V(6); PG8_BAR;
    } else {
        PG8_STAGE(PG8_SB(0, 0), cB, voffB); PG8_STAGE(PG8_SA(0, 0), cA, voffA); PG8_STAGE(PG8_SB(0, 1), cB + hstep, voffB); PG8_STAGE(PG8_SA(0, 1), cA + hstep, voffA);
        if (wr == 1) PG8_BAR;
        PG8_WAIT_V(4); PG8_BAR;
        PG8_STAGE(PG8_SB(1, 0), cB + kstep, voffB); PG8_STAGE(PG8_SA(1, 0), cA + kstep, voffA); PG8_STAGE(PG8_SB(1, 1), cB + hstep + kstep, voffB);
        PG8_WAIT_V(6); PG8_BAR;
    }
    for (;;) {
        const bool has_next = S.next(ui + 1, nxt);
        const char* nA = has_next ? (const char*)g.A + (size_t)nxt.pm * tstep + (size_t)nxt.kc * cstep : cA; const char* nB = has_next ? (const char*)g.Bt + (size_t)nxt.pn * tstep + (size_t)nxt.kc * cstep : cB;
        for (int t = 0; t < nt; t += 2) {
            const bool last = (t == nt - 2);
            const char* a1 = cA + (size_t)(t + 1) * kstep;
            const char* a2 = last ? nA : cA + (size_t)(t + 2) * kstep; const char* b2 = last ? nB : cB + (size_t)(t + 2) * kstep;
            const char* a3 = a2 + kstep; const char* b3 = b2 + kstep;
            if (last && has_next) S.a_ready(nxt);
            if constexpr (SP2) {
            PG8_LDB(B0, 0, 0); PG8_LDB(B1, 0, 1); PG8_SCHED; PG8_LDA(At, 0, 0); PG8_STAGE(PG8_SA(1, 1), a1 + hstep, voffA);
            PG8_WAIT_V(8); PG8_WAIT_L(0); PG8_BAR; PG8_MMA(0, 0, At, B0); PG8_MMA(0, 1, At, B1); PG8_BAR; PG8_SCHED;
            PG8_LDA(At, 0, 1); PG8_STAGE(PG8_SB(0, 0), b2, voffB); PG8_STAGE(PG8_SB(0, 1), b2 + hstep, voffB); PG8_STAGE(PG8_SA(0, 0), a2, voffA);
            PG8_WAIT_V(8); PG8_WAIT_L(0); PG8_BAR; PG8_MMA(1, 0, At, B0); PG8_MMA(1, 1, At, B1); PG8_BAR; PG8_SCHED;
            PG8_LDB(B0, 1, 0); PG8_LDB(B1, 1, 1); PG8_SCHED; PG8_LDA(At, 1, 0); PG8_STAGE(PG8_SA(0, 1), a2 + hstep, voffA);
            PG8_WAIT_V(8); PG8_WAIT_L(0); PG8_BAR; PG8_MMA(0, 0, At, B0); PG8_MMA(0, 1, At, B1); PG8_BAR; PG8_SCHED;
            PG8_LDA(At, 1, 1); PG8_STAGE(PG8_SB(1, 0), b3, voffB); PG8_STAGE(PG8_SB(1, 1), b3 + hstep, voffB); PG8_STAGE(PG8_SA(1, 0), a3, voffA);
            PG8_WAIT_V(8); PG8_WAIT_L(0); PG8_BAR; PG8_MMA(1, 0, At, B0); PG8_MMA(1, 1, At, B1); PG8_BAR; PG8_SCHED;
            } else {
            PG8_LDB(B0, 0, 0); PG8_SCHED; PG8_LDA(At, 0, 0); PG8_STAGE(PG8_SA(1, 1), a1 + hstep, voffA);
            PG8_WAIT_L(8); PG8_BAR; PG8_WAIT_L(0); PG8_MMA(0, 0, At, B0); PG8_BAR; PG8_SCHED;
            PG8_LDB(B1, 0, 1); PG8_STAGE(PG8_SB(0, 0), b2, voffB);
            PG8_BAR; PG8_WAIT_L(0); PG8_MMA(0, 1, At, B1); PG8_BAR;
            PG8_LDA(At, 0, 1); PG8_STAGE(PG8_SA(0, 0), a2, voffA);
            PG8_BAR; PG8_WAIT_L(0); PG8_MMA(1, 0, At, B0); PG8_BAR; PG8_SCHED;
            PG8_STAGE(PG8_SB(0, 1), b2 + hstep, voffB);
            PG8_WAIT_V(6); PG8_BAR; PG8_MMA(1, 1, At, B1); PG8_BAR;
            PG8_LDB(B0, 1, 0); PG8_SCHED; PG8_LDA(At, 1, 0); PG8_STAGE(PG8_SA(0, 1), a2 + hstep, voffA);
            PG8_WAIT_L(8); PG8_BAR; PG8_WAIT_L(0); PG8_MMA(0, 0, At, B0); PG8_BAR; PG8_SCHED;
            PG8_LDB(B1, 1, 1); PG8_STAGE(PG8_SB(1, 0), b3, voffB);
            PG8_BAR; PG8_WAIT_L(0); PG8_MMA(0, 1, At, B1); PG8_BAR;
            PG8_LDA(At, 1, 1); PG8_STAGE(PG8_SA(1, 0), a3, voffA);
            PG8_BAR; PG8_WAIT_L(0); PG8_MMA(1, 0, At, B0); PG8_BAR; PG8_SCHED;
            PG8_STAGE(PG8_SB(1, 1), b3 + hstep, voffB);
            PG8_WAIT_V(6); PG8_BAR; PG8_MMA(1, 1, At, B1); PG8_BAR;
            }
        }
        if constexpr (ALIGN_EPI) { if (wr == 0) PG8_BAR; }
        if constexpr (!Epi::AFTER_DRAIN) { E(acc, cur, wr, wc, fr, fq); S.done(cur); }
        if (!has_next) break;
#pragma unroll
        for (int a = 0; a < 2; ++a)
#pragma unroll
            for (int b = 0; b < 2; ++b)
#pragma unroll
                for (int m = 0; m < 4; ++m)
#pragma unroll
                    for (int n = 0; n < 2; ++n) acc[a][b][m][n] = (f32x4){0.f, 0.f, 0.f, 0.f};
        cur = nxt; cA = nA; cB = nB; ++ui;
        if constexpr (ALIGN_EPI) { if (wr == 1) PG8_BAR; }
    }
    PG8_WAIT_V(0);
    if constexpr (!ALIGN_EPI) { if (wr == 0) PG8_BAR; }
    PG8_BAR;
    if constexpr (Epi::AFTER_DRAIN) { E.fused(acc, cur, wr, wc, fr, fq, lds, wid, lane); S.done(cur); }
#undef PG8_SA
#undef PG8_SB
#undef PG8_STAGE
#undef PG8_LDA
#undef PG8_LDB
#undef PG8_MMA
#undef PG8_WAIT_V
#undef PG8_WAIT_L
#undef PG8_BAR
#undef PG8_SCHED
}
}

#ifndef PG8_SP2
#define PG8_SP2 true
#endif
#ifndef PG8_ALIGN
#define PG8_ALIGN true
#endif
#include <hip/hip_bf16.h>
#include <cmath>
namespace attn_body {
using bf16=__hip_bfloat16;
using bf16x8=__attribute__((ext_vector_type(8)))short;
using s16x4=__attribute__((ext_vector_type(4)))short;
using f32x16=__attribute__((ext_vector_type(16)))float;
using u32x4=__attribute__((ext_vector_type(4)))unsigned;
constexpr int D=64;
constexpr int NW=8,QBLK=32,QB=QBLK*NW,KVBLK=64;
constexpr int ATTN_UNIT_ROWS=QB;
__device__ __forceinline__ int crow(int r,int hi){return (r&3)+8*(r>>2)+4*hi;}
#define SBAR() __builtin_amdgcn_sched_barrier(0)
typedef __attribute__((address_space(3))) const float* lds_cfptr;
__device__ __forceinline__ void namask(f32x16&p0,f32x16&p1,int t,int nabase,int r,int c,int hi,lds_cfptr tb){
  const float NEG=-INFINITY; const int kr=nabase+t-4; int rs=r-4; rs=rs<0?0:(rs>120?120:rs);
  if(kr<rs||kr>=rs+8){
    #pragma unroll
    for(int rr=0;rr<16;++rr){p0[rr]=NEG;p1[rr]=NEG;}
    return; }
  int cs=c-8; cs=cs<0?0:(cs>48?48:cs);
  const int rowi=(kr-r+7)*31+15-c;
  #pragma unroll
  for(int rr=0;rr<16;++rr){ const int j=(rr&3)+8*(rr>>2)+4*hi, j1=j+32;
    const bool v0=(j>=cs)&&(j<cs+16), v1=(j1>=cs)&&(j1<cs+16);
    const float b0=tb[v0?rowi+j:0], b1=tb[v1?rowi+j1:0];
    p0[rr]=v0?p0[rr]+b0:NEG; p1[rr]=v1?p1[rr]+b1:NEG; }
}

typedef unsigned u32x4_t __attribute__((ext_vector_type(4)));
__device__ __forceinline__ bool na_rowok(int t,int nabase,int r){ const int kr=nabase+t-4; int rs=r-4; rs=rs<0?0:(rs>120?120:rs); return kr>=rs&&kr<rs+8; }
__device__ __forceinline__ void na_mfload(u32x4_t*mf,const unsigned*mfh,int t,int nabase,int r,int chalf,int lane){
  const int dr=nabase+t-4-r+7; const u32x4_t*p=(const u32x4_t*)(mfh+(size_t)(((dr*2+chalf)*64+lane)*16));
  #pragma unroll
  for(int i=0;i<4;++i)mf[i]=p[i];
}
__device__ __forceinline__ void na_apply(f32x16&p0,f32x16&p1,const u32x4_t*mf,bool ok){
  if(!ok){ const float NEG=-INFINITY;
    #pragma unroll
    for(int rr=0;rr<16;++rr){p0[rr]=NEG;p1[rr]=NEG;}
    return; }
  #pragma unroll
  for(int rr=0;rr<16;++rr){ const unsigned w0=mf[rr>>3][(rr>>1)&3], w1=mf[2+(rr>>3)][(rr>>1)&3];
    p0[rr]+=__builtin_bit_cast(float,(rr&1)?(w0&0xffff0000u):(w0<<16)); p1[rr]+=__builtin_bit_cast(float,(rr&1)?(w1&0xffff0000u):(w1<<16)); }
}

constexpr int NSLOT=3, SLOTB=8192, VSLOTB=2*SLOTB;
constexpr int LDS_K=0, LDS_V=NSLOT*SLOTB, LDS_WS=LDS_V+NSLOT*VSLOTB, LDS_OST=LDS_WS+NW*64*4, LDS_TB=LDS_OST+NW*4096, LDS_BYTES=LDS_TB+2048;
constexpr float C2=0.125f*1.4426950408889634f;
__device__ __forceinline__ void glds16(const void*gsrc,unsigned lds_dst){unsigned keep;
  asm volatile("s_mov_b32 %0, m0\n\ts_mov_b32 m0, %2\n\ts_nop 0\n\tglobal_load_lds_dwordx4 %1, off\n\ts_mov_b32 m0, %0":"=&s"(keep):"v"(gsrc),"s"(lds_dst):"memory");}
__device__ __forceinline__ float max3f(float a,float b,float c){float r;asm("v_max3_f32 %0, %1, %2, %3":"=v"(r):"v"(a),"v"(b),"v"(c));return r;}
__device__ __forceinline__ float max2f(float a,float b){float r;asm("v_max_f32_e32 %0, %1, %2":"=v"(r):"v"(a),"v"(b));return r;}
__device__ __forceinline__ float fadd_s(float a,float b){float r;asm("v_add_f32_e32 %0, %1, %2":"=v"(r):"v"(a),"v"(b));return r;}
__device__ __forceinline__ float fsub_s(float a,float b){float r;asm("v_sub_f32_e32 %0, %1, %2":"=v"(r):"v"(a),"v"(b));return r;}
typedef float f32x2_t __attribute__((ext_vector_type(2))); typedef __bf16 bf16x2_t __attribute__((ext_vector_type(2)));
__device__ __forceinline__ unsigned cvtpk_s(float lo,float hi){f32x2_t v={lo,hi};bf16x2_t b=__builtin_convertvector(v,bf16x2_t);return __builtin_bit_cast(unsigned,b);}
#define WAIT_BAR(N) asm volatile("s_waitcnt vmcnt(" #N ") lgkmcnt(0)\n\ts_barrier":::"memory")

__device__ __forceinline__ void qkt(f32x16&p0,f32x16&p1,const char*Kslot,const bf16x8*qr,const f32x16&negm,int r32,int hi){
  const char*kb=Kslot+hi*1024+r32*16;
  #pragma unroll
  for(int d0=0;d0<4;++d0){
    const bf16x8 b0=*reinterpret_cast<const bf16x8*>(kb+d0*2048);
    const bf16x8 b1=*reinterpret_cast<const bf16x8*>(kb+d0*2048+512);
    if(d0==0){p0=__builtin_amdgcn_mfma_f32_32x32x16_bf16(b0,qr[0],negm,0,0,0);p1=__builtin_amdgcn_mfma_f32_32x32x16_bf16(b1,qr[0],negm,0,0,0);}
    else{p0=__builtin_amdgcn_mfma_f32_32x32x16_bf16(b0,qr[d0],p0,0,0,0);p1=__builtin_amdgcn_mfma_f32_32x32x16_bf16(b1,qr[d0],p1,0,0,0);}}
}
typedef __attribute__((address_space(3))) const char* lds_cptr;
typedef short v4i16_t __attribute__((ext_vector_type(4)));
__device__ __forceinline__ void kload8(bf16x8*kf,lds_cptr kp){
  kf[0]=*(const __attribute__((address_space(3))) bf16x8*)(kp);      kf[1]=*(const __attribute__((address_space(3))) bf16x8*)(kp+512);
  kf[2]=*(const __attribute__((address_space(3))) bf16x8*)(kp+2048); kf[3]=*(const __attribute__((address_space(3))) bf16x8*)(kp+2560);
  kf[4]=*(const __attribute__((address_space(3))) bf16x8*)(kp+4096); kf[5]=*(const __attribute__((address_space(3))) bf16x8*)(kp+4608);
  kf[6]=*(const __attribute__((address_space(3))) bf16x8*)(kp+6144); kf[7]=*(const __attribute__((address_space(3))) bf16x8*)(kp+6656);
}
__device__ __forceinline__ void kload2(bf16x8*kf,lds_cptr kp,int j){ kf[2*j]=*(const __attribute__((address_space(3))) bf16x8*)(kp+j*2048); kf[2*j+1]=*(const __attribute__((address_space(3))) bf16x8*)(kp+j*2048+512); }
__device__ __forceinline__ s16x4 vtr(lds_cptr p){ return __builtin_bit_cast(s16x4,__builtin_amdgcn_ds_read_tr16_b64_v4i16((__attribute__((address_space(3))) v4i16_t*)p)); }
__device__ __forceinline__ float rowmax(const f32x16&p0,const f32x16&p1){
  float a=max3f(p0[0],p0[1],p1[0]),b=max3f(p0[2],p0[3],p1[1]);a=max3f(a,p1[2],p1[3]);
  #pragma unroll
  for(int r=4;r<16;r+=4){a=max3f(a,p0[r],p0[r+1]);b=max3f(b,p0[r+2],p0[r+3]);a=max3f(a,p1[r],p1[r+1]);b=max3f(b,p1[r+2],p1[r+3]);}
  const float m=max2f(a,b);
  auto rr=__builtin_amdgcn_permlane32_swap(__float_as_uint(m),__float_as_uint(m),false,false);
  return max2f(__uint_as_float(rr[0]),__uint_as_float(rr[1]));
}
__device__ __forceinline__ void pv(f32x16*o,int vb,bf16x8 pa0,bf16x8 pa1,bf16x8 pa2,bf16x8 pa3){
  #pragma unroll
  for(int d0=0;d0<2;++d0){s16x4 lo[4],hi[4];
    #pragma unroll
    for(int ks=0;ks<4;++ks){
      asm volatile("ds_read_b64_tr_b16 %0,%1 offset:%c2":"=&v"(lo[ks]):"v"(vb),"i"(d0*4096+ks*1024):"memory");
      asm volatile("ds_read_b64_tr_b16 %0,%1 offset:%c2":"=&v"(hi[ks]):"v"(vb),"i"(d0*4096+ks*1024+512):"memory");}
    asm volatile("s_waitcnt lgkmcnt(0)":::"memory");SBAR();
    #define PK(k) (bf16x8){lo[k][0],lo[k][1],lo[k][2],lo[k][3],hi[k][0],hi[k][1],hi[k][2],hi[k][3]}
    o[d0]=__builtin_amdgcn_mfma_f32_32x32x16_bf16(pa0,PK(0),o[d0],0,0,0);
    o[d0]=__builtin_amdgcn_mfma_f32_32x32x16_bf16(pa1,PK(1),o[d0],0,0,0);
    o[d0]=__builtin_amdgcn_mfma_f32_32x32x16_bf16(pa2,PK(2),o[d0],0,0,0);
    o[d0]=__builtin_amdgcn_mfma_f32_32x32x16_bf16(pa3,PK(3),o[d0],0,0,0);
    #undef PK
  }
}

#ifndef ATTN_STORE16
#define ATTN_STORE16(p,v) (*(u32x4*)(p)=(v))
#endif
template<int MODE,int THRL> __device__ __forceinline__ void attn_unit(const bf16*Qw0,int PQ,const bf16*__restrict__ Kh,int PK,const bf16*__restrict__ Vh,int PV,bf16*Ow0,int PO,int NT,int nabase,int nar0,const float*rpbh,char*shm){
  int tid_=threadIdx.x; asm volatile("":"+v"(tid_));
  const int tid=tid_,lane=tid&63,r32=lane&31,hi=lane>>5; const int wid=__builtin_amdgcn_readfirstlane(tid>>6);
  const bf16*Qw=Qw0+(long)wid*QBLK*PQ;
  const unsigned lds0=(unsigned)(uintptr_t)shm;
  float*wsf=(float*)(shm+LDS_WS)+wid*64;
  const bf16*ksrc=Kh+(long)lane*PK+wid*8;
  const bf16*vsrc=Vh+(long)(16*(wid&3)+(lane>>2))*PV+(wid>>2)*32+(lane&3)*8;
  const unsigned kdst=lds0+LDS_K+wid*1024, vdst=lds0+LDS_V+wid*1024;
  #define KROW(t) ((t)*KVBLK+((MODE==1&&(t)>=4)?nabase*64:0))
  #define DMA_K(t,slot) glds16(ksrc+(long)KROW(t)*PK,(unsigned)__builtin_amdgcn_readfirstlane(kdst+(slot)))
  #define DMA_V(t,slot) do{ glds16(vsrc+(long)KROW(t)*PV,(unsigned)__builtin_amdgcn_readfirstlane(vdst+2*(slot))); if(MODE==2)glds16(vsrc+(long)KROW(t)*PV+64,(unsigned)__builtin_amdgcn_readfirstlane(vdst+2*(slot)+SLOTB)); }while(0)
  const int vb0=(int)(lds0+LDS_V)+((lane>>4)&1)*32+(lane&3)*8+(4*hi+((lane&15)>>2))*64;
  const char*Kbase=shm+LDS_K; bf16x8 kf[8];
  const lds_cptr shm3=(lds_cptr)shm; const lds_cptr kp0=shm3+LDS_K+hi*1024+r32*16; const lds_cptr vp0=shm3+LDS_V+((lane>>4)&1)*32+(lane&3)*8+(4*hi+((lane&15)>>2))*64;
  const lds_cfptr tb=(lds_cfptr)(shm3+LDS_TB);
  u32x4_t mf[4];
  const int nar=nar0+(wid>>1), nac=(wid&1)*32+r32;
  DMA_K(0,0);DMA_V(0,0);DMA_K(1,SLOTB);
  bf16x8 qr[4];
  #pragma unroll
  for(int d0=0;d0<4;++d0)qr[d0]=*reinterpret_cast<const bf16x8*>(&Qw[(long)r32*PQ+d0*16+hi*8]);
  float mhat=0.f,l_reg=0.f;constexpr int ND=(MODE==2)?4:2; f32x16 o[4];o[0]=f32x16{};o[1]=f32x16{};o[2]=f32x16{};o[3]=f32x16{};f32x16 negm=f32x16{};asm volatile("":"+v"(negm));
  #define CMASK(P0,P1,t) do{ if(MODE==1&&(t)>=4)na_apply(P0,P1,mf,na_rowok((t),nabase,nar)); }while(0)
  #define MFLOAD(tn) do{ if(MODE==1&&(tn)>=4&&(tn)<NT){ if(na_rowok((tn),nabase,nar))na_mfload(mf,(const unsigned*)rpbh,(tn),nabase,nar,wid&1,lane); } }while(0)
  bool resc=false;
  #define START(P0,P1) do{ const float rm=rowmax(P0,P1); resc=false; \
    { const float dl=rm; mhat=fadd_s(mhat,dl); \
      _Pragma("unroll") for(int r=0;r<16;++r){P0[r]=fsub_s(P0[r],dl);P1[r]=fsub_s(P1[r],dl);} \
      _Pragma("unroll") for(int r=0;r<16;++r)negm[r]=-mhat; asm volatile("":"+v"(negm)); } \
    _Pragma("unroll") for(int r=0;r<16;++r)P0[r]=__builtin_amdgcn_exp2f(P0[r]); }while(0)
  #define RESC() do{ if(resc){ asm volatile("s_waitcnt lgkmcnt(0)":::"memory"); \
      _Pragma("unroll") for(int d_=0;d_<ND;++d_) _Pragma("unroll") for(int r=0;r<16;++r)o[d_][r]*=wsf[crow(r,hi)]; } }while(0)
  f32x16 pA0,pA1,pB0,pB1;
  int sl_prev=0,sl_cur=0,sl_next=SLOTB;
  #define ROT() do{sl_prev=sl_cur;sl_cur=sl_next;sl_next=(sl_next==(NSLOT-1)*SLOTB)?0:sl_next+SLOTB;}while(0)
  DMA_K(2,2*SLOTB);
  if(MODE==2){WAIT_BAR(4);}else{WAIT_BAR(3);}
  qkt(pA0,pA1,Kbase,qr,negm,r32,hi);asm volatile("s_nop 15\n\ts_nop 7":"+v"(pA0),"+v"(pA1));CMASK(pA0,pA1,0);
  START(pA0,pA1);
  _Pragma("unroll") for(int r=0;r<16;++r)pA1[r]=__builtin_amdgcn_exp2f(pA1[r]);
  WAIT_BAR(0);
  DMA_K(3,0);DMA_V(1,SLOTB);
  ROT();
  kload8(kf,kp0+sl_cur);
  if(MODE==2){WAIT_BAR(3);}else{WAIT_BAR(2);}
  s16x4 vlo[8],vhi[8]; u32x4 pw0,pw1,pw2,pw3;
  #define PKW(P,B) cvtpk_s(P[B],P[B+1])
  #define PAF(k) __builtin_bit_cast(bf16x8,pw##k)
  #define VFR(i) (bf16x8){vlo[i][0],vlo[i][1],vlo[i][2],vlo[i][3],vhi[i][0],vhi[i][1],vhi[i][2],vhi[i][3]}
  #define PIN(x) asm volatile("":"+v"(x))
  #define MX3(a,b,c) __builtin_fmaxf(__builtin_fmaxf((a),(b)),(c))
  #define GAPA(MF,A0,A1,A2,A3,W0,W1,PW) do{ MF; sacc+=A0; sacc+=A1; sacc+=A2; sacc+=A3; PIN(sacc); W0; W1; PIN(PW); SBAR(); }while(0)
  #define EX(v) __builtin_amdgcn_exp2f(v)
  #define GAPB(MF,X,B) do{ MF; X[B]=EX(X[B]); X[B+1]=EX(X[B+1]); X[B+2]=EX(X[B+2]); X[B+3]=EX(X[B+3]); PIN(X); SBAR(); }while(0)
  #define GAPB2(MF,X,B) do{ MF; X[B]=EX(X[B]); X[B+1]=EX(X[B+1]); PIN(X); SBAR(); }while(0)
  #define GAPB3(MF,X,A,Y,B,Z,C) do{ MF; X[A]=EX(X[A]); Y[B]=EX(Y[B]); Z[C]=EX(Z[C]); PIN(X); PIN(Z); SBAR(); }while(0)
  #define VRD(i) do{ vlo[i]=vtr(vp_+(((i)>>2)*4096+((i)&3)*1024)); vhi[i]=vtr(vp_+(((i)>>2)*4096+((i)&3)*1024+512)); }while(0)
  #define VRD2(i) do{ if(MODE==2){ vlo[i]=vtr(vp_+(SLOTB+((i)>>2)*4096+((i)&3)*1024)); vhi[i]=vtr(vp_+(SLOTB+((i)>>2)*4096+((i)&3)*1024+512)); SBAR(); } }while(0)
  #define KRD(G,j) do{ if(G){ kload2(kf,kp0+sl_next,j); SBAR(); } }while(0)
  #define STEP(C0,C1,P0,P1,t,GK,GV,GL) do{ SBAR(); \
    const lds_cptr vp_=vp0+2*sl_prev; \
    VRD(0); SBAR(); float sacc=(P0[0]+P0[1]); \
    GAPA(C0=__builtin_amdgcn_mfma_f32_32x32x16_bf16(kf[0],qr[0],negm,0,0,0), P0[2],P0[3],P0[4],P0[5],     pw0[0]=PKW(P0,0), pw0[1]=PKW(P0,2), pw0); \
    VRD(4); SBAR(); GAPA(C1=__builtin_amdgcn_mfma_f32_32x32x16_bf16(kf[1],qr[0],negm,0,0,0), P0[6],P0[7],P0[8],P0[9],     pw0[2]=PKW(P0,4), pw0[3]=PKW(P0,6), pw0); \
    VRD(1); SBAR(); GAPA(C0=__builtin_amdgcn_mfma_f32_32x32x16_bf16(kf[2],qr[1],C0,0,0,0),   P0[10],P0[11],P0[12],P0[13], pw1[0]=PKW(P0,8), pw1[1]=PKW(P0,10), pw1); \
    VRD(5); SBAR(); GAPA(C1=__builtin_amdgcn_mfma_f32_32x32x16_bf16(kf[3],qr[1],C1,0,0,0),   P0[14],P0[15],P1[0],P1[1],   pw1[2]=PKW(P0,12),pw1[3]=PKW(P0,14), pw1); \
    VRD(2); SBAR(); GAPA(C0=__builtin_amdgcn_mfma_f32_32x32x16_bf16(kf[4],qr[2],C0,0,0,0),   P1[2],P1[3],P1[4],P1[5],     pw2[0]=PKW(P1,0), pw2[1]=PKW(P1,2), pw2); \
    VRD(6); SBAR(); GAPA(C1=__builtin_amdgcn_mfma_f32_32x32x16_bf16(kf[5],qr[2],C1,0,0,0),   P1[6],P1[7],P1[8],P1[9],     pw2[2]=PKW(P1,4), pw2[3]=PKW(P1,6), pw2); \
    VRD(3); SBAR(); GAPA(C0=__builtin_amdgcn_mfma_f32_32x32x16_bf16(kf[6],qr[3],C0,0,0,0),   P1[10],P1[11],P1[12],P1[13], pw3[0]=PKW(P1,8), pw3[1]=PKW(P1,10), pw3); \
    VRD(7); SBAR(); GAPA(C1=__builtin_amdgcn_mfma_f32_32x32x16_bf16(kf[7],qr[3],C1,0,0,0),   P1[14],P1[15],0.f,0.f,       pw3[2]=PKW(P1,12),pw3[3]=PKW(P1,14), pw3); \
    l_reg+=sacc; \
    CMASK(C0,C1,t); MFLOAD((t)+1); \
    if(GK){DMA_K((t)+3,sl_cur);} if(GV){DMA_V((t)+1,sl_next);} \
    if(MODE==2){   \
      o[0]=__builtin_amdgcn_mfma_f32_32x32x16_bf16(PAF(0),VFR(0),o[0],0,0,0); VRD2(0); \
      o[1]=__builtin_amdgcn_mfma_f32_32x32x16_bf16(PAF(0),VFR(4),o[1],0,0,0); VRD2(4); \
      o[0]=__builtin_amdgcn_mfma_f32_32x32x16_bf16(PAF(1),VFR(1),o[0],0,0,0); VRD2(1); } \
    { float a=MX3(C0[0],C0[1],C1[0]),b=MX3(C0[2],C0[3],C1[1]); a=MX3(a,C1[2],C1[3]); \
      _Pragma("unroll") for(int r=4;r<16;r+=4){a=MX3(a,C0[r],C0[r+1]);b=MX3(b,C0[r+2],C0[r+3]);a=MX3(a,C1[r],C1[r+1]);b=MX3(b,C1[r+2],C1[r+3]);} \
      float rm=__builtin_fmaxf(a,b); { auto rr=__builtin_amdgcn_permlane32_swap(__float_as_uint(rm),__float_as_uint(rm),false,false); rm=__builtin_fmaxf(__uint_as_float(rr[0]),__uint_as_float(rr[1])); } \
      resc=false; \
      if(__builtin_expect(__any(rm>(float)THRL),0)){ const float dl=__builtin_fmaxf(rm,0.f); mhat+=dl; \
        _Pragma("unroll") for(int r=0;r<16;++r){C0[r]-=dl;C1[r]-=dl;} \
        _Pragma("unroll") for(int r=0;r<16;++r)negm[r]=-mhat; asm volatile("":"+v"(negm)); \
        const float f=__builtin_amdgcn_exp2f(-dl); l_reg*=f; if(hi==0)wsf[r32]=f; resc=true; } } \
    SBAR(); \
    if(MODE!=2){ \
    GAPB(o[0]=__builtin_amdgcn_mfma_f32_32x32x16_bf16(PAF(0),VFR(0),o[0],0,0,0), C0,0); \
    GAPB(o[1]=__builtin_amdgcn_mfma_f32_32x32x16_bf16(PAF(0),VFR(4),o[1],0,0,0), C0,4); \
    KRD(GL,0); GAPB(o[0]=__builtin_amdgcn_mfma_f32_32x32x16_bf16(PAF(1),VFR(1),o[0],0,0,0), C0,8); \
    KRD(GL,1); GAPB(o[1]=__builtin_amdgcn_mfma_f32_32x32x16_bf16(PAF(1),VFR(5),o[1],0,0,0), C0,12); \
    KRD(GL,2); GAPB(o[0]=__builtin_amdgcn_mfma_f32_32x32x16_bf16(PAF(2),VFR(2),o[0],0,0,0), C1,0); \
    KRD(GL,3); GAPB(o[1]=__builtin_amdgcn_mfma_f32_32x32x16_bf16(PAF(2),VFR(6),o[1],0,0,0), C1,4); \
    GAPB(o[0]=__builtin_amdgcn_mfma_f32_32x32x16_bf16(PAF(3),VFR(3),o[0],0,0,0), C1,8); \
    GAPB(o[1]=__builtin_amdgcn_mfma_f32_32x32x16_bf16(PAF(3),VFR(7),o[1],0,0,0), C1,12); \
    } else {   \
    KRD(GL,0); GAPB3(o[1]=__builtin_amdgcn_mfma_f32_32x32x16_bf16(PAF(1),VFR(5),o[1],0,0,0), C0,0,C0,1,C0,2); VRD2(5); \
    KRD(GL,1); GAPB3(o[0]=__builtin_amdgcn_mfma_f32_32x32x16_bf16(PAF(2),VFR(2),o[0],0,0,0), C0,3,C0,4,C0,5); VRD2(2); \
    KRD(GL,2); GAPB3(o[1]=__builtin_amdgcn_mfma_f32_32x32x16_bf16(PAF(2),VFR(6),o[1],0,0,0), C0,6,C0,7,C0,8); VRD2(6); \
    KRD(GL,3); GAPB3(o[0]=__builtin_amdgcn_mfma_f32_32x32x16_bf16(PAF(3),VFR(3),o[0],0,0,0), C0,9,C0,10,C0,11); VRD2(3); \
    GAPB3(o[1]=__builtin_amdgcn_mfma_f32_32x32x16_bf16(PAF(3),VFR(7),o[1],0,0,0), C0,12,C0,13,C0,14); VRD2(7); \
    GAPB3(o[2]=__builtin_amdgcn_mfma_f32_32x32x16_bf16(PAF(0),VFR(0),o[2],0,0,0), C0,15,C1,0,C1,1); \
    GAPB2(o[3]=__builtin_amdgcn_mfma_f32_32x32x16_bf16(PAF(0),VFR(4),o[3],0,0,0), C1,2); \
    GAPB2(o[2]=__builtin_amdgcn_mfma_f32_32x32x16_bf16(PAF(1),VFR(1),o[2],0,0,0), C1,4); \
    GAPB2(o[3]=__builtin_amdgcn_mfma_f32_32x32x16_bf16(PAF(1),VFR(5),o[3],0,0,0), C1,6); \
    GAPB2(o[2]=__builtin_amdgcn_mfma_f32_32x32x16_bf16(PAF(2),VFR(2),o[2],0,0,0), C1,8); \
    GAPB2(o[3]=__builtin_amdgcn_mfma_f32_32x32x16_bf16(PAF(2),VFR(6),o[3],0,0,0), C1,10); \
    GAPB2(o[2]=__builtin_amdgcn_mfma_f32_32x32x16_bf16(PAF(3),VFR(3),o[2],0,0,0), C1,12); \
    GAPB2(o[3]=__builtin_amdgcn_mfma_f32_32x32x16_bf16(PAF(3),VFR(7),o[3],0,0,0), C1,14); \
    } \
    }while(0)
  int t=1;
  for(;t+5<NT;t+=2){
    STEP(pB0,pB1,pA0,pA1,t,true,true,true);     if(MODE==2){WAIT_BAR(3);}else{WAIT_BAR(2);} RESC(); ROT();
    STEP(pA0,pA1,pB0,pB1,t+1,true,true,true);   if(MODE==2){WAIT_BAR(3);}else{WAIT_BAR(2);} RESC(); ROT();
  }
  #define CMASK_DUP(P0,P1,t) do{ if(MODE==1&&(t)>=4)namask(P0,P1,(t),nabase,nar,nac,hi,tb); }while(0)
  #define ENDW(tt) do{ if((tt)+3<NT){ if(MODE==2){WAIT_BAR(3);}else{WAIT_BAR(2);} } else if((tt)+2<NT){ if(MODE==2){WAIT_BAR(2);}else{WAIT_BAR(1);} } else {WAIT_BAR(0);} }while(0)
  for(;t+1<NT;t+=2){
    STEP(pB0,pB1,pA0,pA1,t,(t+3<NT),(t+1<NT),(t+1<NT));       ENDW(t);   RESC(); ROT();
    STEP(pA0,pA1,pB0,pB1,t+1,(t+4<NT),(t+2<NT),(t+2<NT));     ENDW(t+1); RESC(); ROT();
  }
  STEP(pB0,pB1,pA0,pA1,NT-1,false,false,false); RESC();
  { float sacc=pB0[0]+pB0[1]; _Pragma("unroll") for(int r=2;r<16;++r)sacc+=pB0[r]; _Pragma("unroll") for(int r=0;r<16;++r)sacc+=pB1[r]; l_reg+=sacc;
    pw0=(u32x4){PKW(pB0,0),PKW(pB0,2),PKW(pB0,4),PKW(pB0,6)};pw1=(u32x4){PKW(pB0,8),PKW(pB0,10),PKW(pB0,12),PKW(pB0,14)};pw2=(u32x4){PKW(pB1,0),PKW(pB1,2),PKW(pB1,4),PKW(pB1,6)};pw3=(u32x4){PKW(pB1,8),PKW(pB1,10),PKW(pB1,12),PKW(pB1,14)};
    SBAR(); pv(o,vb0+2*sl_cur,PAF(0),PAF(1),PAF(2),PAF(3)); if(MODE==2){ SBAR(); pv(o+2,vb0+2*sl_cur+SLOTB,PAF(0),PAF(1),PAF(2),PAF(3)); } }
  #undef PKW
  #undef PAF
  #undef VFR
  #undef PIN
  #undef MX3
  #undef GAPA
  #undef GAPB
  #undef GAPB2
  #undef GAPB3
  #undef EX
  #undef VRD
  #undef VRD2
  #undef KRD
  #undef STEP
  #undef ENDW
  {auto rr=__builtin_amdgcn_permlane32_swap(__float_as_uint(l_reg),__float_as_uint(l_reg),false,false);l_reg=__uint_as_float(rr[0])+__uint_as_float(rr[1]);}
  if(hi==0)wsf[32+r32]=l_reg;asm volatile("s_waitcnt lgkmcnt(0)":::"memory");
  float rli[16];
  #pragma unroll
  for(int r=0;r<16;++r)rli[r]=__builtin_amdgcn_rcpf(wsf[32+crow(r,hi)]);
  bf16*Ow=Ow0+(long)wid*QBLK*PO;
  { bf16*stg=(bf16*)(shm+LDS_OST)+wid*2048;
    #pragma unroll
    for(int hf=0;hf<ND/2;++hf){
    #pragma unroll
    for(int r=0;r<16;++r){const int orow=crow(r,hi);
      #pragma unroll
      for(int d0=0;d0<2;++d0)stg[orow*64+d0*32+r32]=__float2bfloat16(o[2*hf+d0][r]*rli[r]);}
    asm volatile("s_waitcnt lgkmcnt(0)":::"memory");
    #pragma unroll
    for(int i=0;i<4;++i){const int row=i*8+(lane>>3),ch=lane&7; const u32x4 v=*(const u32x4*)(stg+row*64+ch*8); ATTN_STORE16(Ow+(long)row*PO+hf*64+ch*8,v);}
    asm volatile("s_waitcnt lgkmcnt(0)":::"memory"); } }
  asm volatile("s_waitcnt lgkmcnt(0)\n\ts_barrier":::"memory");
  #undef DMA_K
  #undef DMA_V
  #undef KROW
  #undef CMASK_DUP
  #undef CMASK
  #undef MFLOAD
  #undef START
  #undef RESC
  #undef ROT
}
constexpr int ATTN_LDS_BYTES=LDS_BYTES;
#undef SBAR
#undef WAIT_BAR
}
constexpr int DMODEL = 1024, NBATCH = 4, SEQ = 8192, CTXL = 256, TPB = SEQ + CTXL  , MROWS = NBATCH * TPB  , DFF = 2816;
constexpr int PAR_IN = 2304, DIFF_IN = 3072, NMOD6 = 6 * DMODEL;
constexpr float EPS = 1e-6f;
constexpr float LAMBDA_INIT = 0.35550906759096925f;
constexpr int NWAVES = 8, NTHREADS = NWAVES * 64;
constexpr size_t WS_W_IN0 = 0;
constexpr size_t WS_W_OUT0 = WS_W_IN0 + (size_t)PAR_IN * DMODEL * 2;
constexpr size_t WS_W_GU0 = WS_W_OUT0 + (size_t)DMODEL * DMODEL * 2;
constexpr size_t WS_W_DN0 = WS_W_GU0 + (size_t)2 * DFF * DMODEL * 2;
constexpr size_t WS_W_IN1 = WS_W_DN0 + (size_t)DMODEL * DFF * 2;
constexpr size_t WS_W_OUT1 = WS_W_IN1 + (size_t)DIFF_IN * DMODEL * 2;
constexpr size_t WS_W_GU1 = WS_W_OUT1 + (size_t)DMODEL * DMODEL * 2;
constexpr size_t WS_W_DN1 = WS_W_GU1 + (size_t)2 * DFF * DMODEL * 2;
constexpr size_t WS_MOD = WS_W_DN1 + (size_t)DMODEL * DFF * 2;
constexpr size_t WS_ROPE = WS_MOD + (size_t)2 * 5 * NMOD6 * 4;
constexpr size_t WS_X = WS_ROPE + (size_t)128 * 16 * 2 * 4;
constexpr size_t WS_XN = WS_X + (size_t)MROWS * DMODEL * 4;
constexpr size_t WS_QKV = WS_XN + (size_t)MROWS * DMODEL * 2;
constexpr size_t WS_END = WS_QKV + (size_t)MROWS * DIFF_IN * 2;
constexpr size_t WS_PART = WS_END + 65536;
static_assert(WS_PART + (size_t)11 * 1024 * 1024 * 4 <= (size_t)512 * 1024 * 1024, "d_ws map");
constexpr size_t WS_MF = WS_PART + (size_t)11 * 1024 * 1024 * 4;
static_assert(WS_MF + (size_t)8 * 15 * 2 * 64 * 32 * 4 <= (size_t)512 * 1024 * 1024, "d_ws map");
constexpr size_t WS_CTL = WS_END;
static_assert(WS_CTL + 65536 <= (size_t)512 * 1024 * 1024 && WS_X % 256 == 0 && WS_XN % 256 == 0 && WS_QKV % 256 == 0 && WS_MOD % 256 == 0, "d_ws map");
constexpr int LDS_TOTAL = 147456;
static_assert(attn_body::ATTN_LDS_BYTES <= pg8::STAGE_BYTES && pg8::STAGE_BYTES <= LDS_TOTAL, "LDS map");

#define LAS __attribute__((address_space(3)))
typedef unsigned short bf16;
typedef unsigned v4u __attribute__((ext_vector_type(4)));
typedef unsigned v2u __attribute__((ext_vector_type(2)));
typedef float f32x4 __attribute__((ext_vector_type(4)));
__device__ __forceinline__ unsigned f2bf(float f) { unsigned u = __builtin_bit_cast(unsigned, f); return (u + 0x7fffu + ((u >> 16) & 1u)) >> 16; }
__device__ __forceinline__ unsigned pk2(float lo, float hi) { return f2bf(lo) | (f2bf(hi) << 16); }
__device__ __forceinline__ float bflo(unsigned w) { return __builtin_bit_cast(float, w << 16); }
__device__ __forceinline__ float bfhi(unsigned w) { return __builtin_bit_cast(float, w & 0xffff0000u); }
__device__ __forceinline__ float wave_sum(float v) {
#pragma unroll
    for (int o = 1; o < 64; o <<= 1) v += __shfl_xor(v, o);
    return v;
}
struct Args {
    const float *x, *c, *ctx, *c_ctx, *ada_w, *ada_b, *w_gate, *w_up, *w_down, *par_w_in, *par_w_out, *na_rpb, *q_gain, *k_gain, *diff_w_in, *diff_w_out, *lq1, *lk1, *lq2, *lk2, *subln, *fgain;
    float* out; unsigned char* ws;
};
__device__ __forceinline__ void transpose_item(const float* W, int K, int N, bf16* WT, LAS float* scr, int k0, int n0, int wrow0, int lane) {
    float tv[32];
#pragma unroll
    for (int i = 0; i < 32; ++i) tv[i] = W[(size_t)(k0 + 2 * i + (lane >> 5)) * N + n0 + (lane & 31)];
#pragma unroll
    for (int i = 0; i < 32; ++i) scr[(2 * i + (lane >> 5)) * 33 + (lane & 31)] = tv[i];
    asm volatile("s_waitcnt lgkmcnt(0)" ::: "memory");
    const int c = lane & 7;
#pragma unroll
    for (int j = 0; j < 4; ++j) { const int n = (lane >> 3) + 8 * j; const LAS float* s = scr + (8 * c) * 33 + n;
        v4u o; o.x = pk2(s[0 * 33], s[1 * 33]); o.y = pk2(s[2 * 33], s[3 * 33]); o.z = pk2(s[4 * 33], s[5 * 33]); o.w = pk2(s[6 * 33], s[7 * 33]);
        *(v4u*)(WT + (size_t)(wrow0 + n) * K + k0 + 8 * c) = o; }
    asm volatile("s_waitcnt lgkmcnt(0)" ::: "memory");
}
__device__ __forceinline__ bool transpose_mat(int& r, const float* W, int K, int N, bf16* WT, int gu, LAS float* scr, int lane) {
    const int nblk = N / 32, cnt = (K / 64) * nblk;
    if (r >= cnt) { r -= cnt; return false; }
    const int kb = r / nblk, nb = r % nblk, n0 = 32 * nb;
    const int wrow0 = gu ? (256 * (n0 / 128) + 128 * (gu - 1) + (n0 % 128)) : n0;
    transpose_item(W, K, N, WT, scr, 64 * kb, n0, wrow0, lane); return true;
}
__device__ __forceinline__ const float* row_src(int row, const float* lat, long lat_bs, const float* cx, long ctx_bs, int& s) {
    const int b = row / TPB, t = row - b * TPB;
    if (t < CTXL) { s = 4; return cx + (size_t)b * ctx_bs + (size_t)t * DMODEL; }
    s = b; return lat + (size_t)b * lat_bs + (size_t)(t - CTXL) * DMODEL;
}
__device__ __forceinline__ void norm_mod_phase(const float* lat, long lat_bs, const float* cx, long ctx_bs, const float* modl, int shoff, int scoff, bf16* XN, int skip_ctx, int gw, int NGW, float* xcopy, const float* part, int nkc, const float* pgate) {
    int t_ = threadIdx.x; asm volatile("" : "+v"(t_)); const int lane = t_ & 63;
    f32x4 vn[4]; int sn = 0;
    { if (gw < MROWS) { const float* src = row_src(gw, lat, lat_bs, cx, ctx_bs, sn); const f32x4* xr = (const f32x4*)src + lane;
#pragma unroll
        for (int j = 0; j < 4; ++j) vn[j] = xr[64 * j]; } }
    for (int row = gw; row < MROWS; row += NGW) {
        const int s = sn; f32x4 v[4]; float ss = 0.f;
#pragma unroll
        for (int j = 0; j < 4; ++j) v[j] = vn[j];
        if (row + NGW < MROWS) { const float* srcn = row_src(row + NGW, lat, lat_bs, cx, ctx_bs, sn); const f32x4* xr = (const f32x4*)srcn + lane;
#pragma unroll
            for (int j = 0; j < 4; ++j) vn[j] = xr[64 * j]; }
        if (skip_ctx && s == 4) continue;
#pragma unroll
        for (int j = 0; j < 4; ++j) ss += (v[j].x * v[j].x + v[j].y * v[j].y) + (v[j].z * v[j].z + v[j].w * v[j].w);
        if (xcopy && s == 4) {
            const int b_ = row / TPB, cr = b_ * CTXL + (row - b_ * TPB); const f32x4* gp = (const f32x4*)(pgate + 4 * NMOD6) + lane;
            f32x4 sm[4];
#pragma unroll
            for (int j = 0; j < 4; ++j) sm[j] = (f32x4){0.f, 0.f, 0.f, 0.f};
            for (int kc = 0; kc < nkc; ++kc) { const f32x4* pp = (const f32x4*)(part + ((size_t)kc * 1024 + cr) * DMODEL) + lane;
#pragma unroll
                for (int j = 0; j < 4; ++j) sm[j] += pp[64 * j]; }
            f32x4* xc = (f32x4*)(xcopy + (size_t)row * DMODEL) + lane; ss = 0.f;
#pragma unroll
            for (int j = 0; j < 4; ++j) { v[j] += gp[64 * j] * sm[j]; xc[64 * j] = v[j]; ss += (v[j].x * v[j].x + v[j].y * v[j].y) + (v[j].z * v[j].z + v[j].w * v[j].w); } }
        const float rstd = 1.0f / sqrtf(wave_sum(ss) * (1.0f / DMODEL) + EPS);
        const f32x4* sh = (const f32x4*)(modl + s * NMOD6 + shoff) + lane; const f32x4* sc = (const f32x4*)(modl + s * NMOD6 + scoff) + lane;
        v2u* o8 = (v2u*)(XN + (size_t)row * DMODEL) + lane;
#pragma unroll
        for (int j = 0; j < 4; ++j) { const f32x4 a = sh[64 * j], m = sc[64 * j]; const f32x4 y = v[j] * rstd * (m + 1.0f) + a; v2u w; w.x = pk2(y.x, y.y); w.y = pk2(y.z, y.w); o8[64 * j] = w; }
    }
}
typedef __attribute__((address_space(1))) unsigned gu32;
#define XB_TMO      128
#define XB_XCNT(j)  (256  + 64 * (j))
#define XB_XSUB(j)  (1280 + 64 * (j))
#define XB_XGEN(j)  (2304 + 64 * (j))
#define XB_TOP      3328
#define XB_TOPGEN   3392
#define XCD_BAR_WORDS 3456
#define XB_SPIN_CAP (1u << 18)

__device__ __forceinline__ unsigned xb_ld(unsigned* p)              { return __hip_atomic_load(p, __ATOMIC_RELAXED, __HIP_MEMORY_SCOPE_AGENT); }
__device__ __forceinline__ unsigned xb_add(unsigned* p, unsigned v) { return __hip_atomic_fetch_add(p, v, __ATOMIC_RELAXED, __HIP_MEMORY_SCOPE_AGENT); }
__device__ __forceinline__ unsigned xb_xcc_id() { return (unsigned)__builtin_amdgcn_s_getreg((3 << 11) | 20) & 0xFu; }
#define XB_SPIN(cond, bar) do { unsigned _sp = 0; while (cond) { __builtin_amdgcn_s_sleep(1); \
    if ((++_sp & 255u) == 0u) { if (xb_ld(&(bar)[XB_TMO])) break; if (_sp > XB_SPIN_CAP) { atomicAdd(&(bar)[XB_TMO], 1u); break; } } } } while (0)

struct XcdBarrier {
    unsigned* bar; unsigned x;
    volatile LAS unsigned* st;
};

__device__ __forceinline__ XcdBarrier xcd_barrier_post(unsigned* bar, volatile LAS unsigned* st) {
    XcdBarrier b; b.bar = bar; b.x = xb_xcc_id(); b.st = st;
    if (threadIdx.x == 0) (void)xb_add(&bar[XB_XCNT(b.x)], 1u);
    return b;
}
__device__ __forceinline__ void xcd_barrier_complete(unsigned* bar, unsigned x, unsigned& nloc, unsigned& nx) {
    const unsigned G = gridDim.x * gridDim.y * gridDim.z;
    unsigned sum, cnt, mine, sp = 0u;
    for (;;) {
        sum = 0u; cnt = 0u; mine = 0u;
#pragma unroll
        for (unsigned j = 0; j < 16; ++j) { const unsigned c = xb_ld(&bar[XB_XCNT(j)]); sum += c; cnt += (c > 0u) ? 1u : 0u; mine = (j == x) ? c : mine; }
        if (sum == G) break;
        __builtin_amdgcn_s_sleep(1);
        if ((++sp & 255u) == 0u) { if (xb_ld(&bar[XB_TMO])) break; if (sp > XB_SPIN_CAP) { atomicAdd(&bar[XB_TMO], 1u); break; } }
    }
    nloc = mine > 0u ? mine : 1u; nx = cnt > 0u ? cnt : 1u;
}

__device__ __forceinline__ void xcd_barrier(const XcdBarrier& b) {
    asm volatile("s_waitcnt vmcnt(0)" ::: "memory");
    __syncthreads();
    if (threadIdx.x == 0) {
        unsigned* bar = b.bar;
        __builtin_amdgcn_s_waitcnt(0);
        unsigned nloc = b.st[0], nx = b.st[1];
        if (nloc == 0u) { xcd_barrier_complete(bar, b.x, nloc, nx); b.st[0] = nloc; b.st[1] = nx; }
        const unsigned old = xb_add(&bar[XB_XSUB(b.x)], 1u);
        const unsigned gen = old / nloc;
        if (old + 1u == (gen + 1u) * nloc) {
            __builtin_amdgcn_fence(__ATOMIC_RELEASE, "agent");
            asm volatile("s_waitcnt vmcnt(0)" ::: "memory");
            const unsigned og = xb_add(&bar[XB_TOP], 1u);
            const unsigned tg = og / nx;
            if (og + 1u == (tg + 1u) * nx) xb_add(&bar[XB_TOPGEN], 1u);
            else XB_SPIN(xb_ld(&bar[XB_TOPGEN]) == tg, bar);
            __builtin_amdgcn_fence(__ATOMIC_ACQUIRE, "agent");
            xb_add(&bar[XB_XGEN(b.x)], 1u);
            asm volatile("s_waitcnt vmcnt(0)" ::: "memory");
        } else {
            XB_SPIN(xb_ld(&bar[XB_XGEN(b.x)]) == gen, bar);
            __builtin_amdgcn_fence(__ATOMIC_ACQUIRE, "agent");
            asm volatile("s_waitcnt vmcnt(0)" ::: "memory");
        }
    }
    __syncthreads();
}

#define FRESH_LANE() ({ int t_ = threadIdx.x; asm volatile("" : "+v"(t_)); t_ & 63; })
struct AttnDesc { const attn_body::bf16 *Q, *K, *V; attn_body::bf16* O; int PQ, PK, PV, PO, NT; };

#define W_IN(l) ((bf16*)(ws + ((l) ? WS_W_IN1 : WS_W_IN0)))
#define W_OUT(l) ((bf16*)(ws + ((l) ? WS_W_OUT1 : WS_W_OUT0)))
#define W_GU(l) ((bf16*)(ws + ((l) ? WS_W_GU1 : WS_W_GU0)))
#define W_DN(l) ((bf16*)(ws + ((l) ? WS_W_DN1 : WS_W_DN0)))
template <int l> __device__ __forceinline__ void layer_body(const Args& a, unsigned char* lds, const XcdBarrier& bar, int G, int bx, int vcu, int gw, int NGW, int lane_, int tid_k, int wave) {
    unsigned char* ws = a.ws;
    float* MOD = (float*)(ws + WS_MOD); float* ROPE = (float*)(ws + WS_ROPE); float* X = (float*)(ws + WS_X);
    bf16* XN = (bf16*)(ws + WS_XN); bf16* QKV = (bf16*)(ws + WS_QKV); bf16* HB = QKV; bf16* AO = XN; bf16* OP = (bf16*)a.out;
    LAS unsigned char* ldsl = (LAS unsigned char*)lds;
        const float* modl = MOD + (size_t)l * 5 * NMOD6;
        const int last = (l == 1);
        const float* lat = l == 0 ? a.x : X + (size_t)CTXL * DMODEL; const long lat_bs = l == 0 ? (long)SEQ * DMODEL : (long)TPB * DMODEL;
        const float* cxs = l == 0 ? a.ctx : X; const long ctx_bs = l == 0 ? (long)CTXL * DMODEL : (long)TPB * DMODEL;
        norm_mod_phase(lat, lat_bs, cxs, ctx_bs, modl, 0, DMODEL, XN, 0, gw, NGW, l == 1 ? X : nullptr, (const float*)(ws + WS_PART), 11, MOD + 5 * DMODEL);
        xcd_barrier(bar);
        {
            if constexpr (l == 0) {
                pg8::Gemm g{XN, W_IN(0), MROWS, PAR_IN, DMODEL, DMODEL}; pg8::StaticOrder S; S.init(MROWS, PAR_IN, G, bx);
                pg8::EpiBf16<0> E{QKV, PAR_IN, nullptr, 512, 512, attn_body::C2};
                pg8::gemm_phase<pg8::EpiBf16<0>, pg8::StaticOrder, PG8_ALIGN, PG8_SP2>(ldsl, g, S, E);
            } else {
                pg8::Gemm g{XN, W_IN(1), MROWS, DIFF_IN, DMODEL, DMODEL}; pg8::StaticOrder S; S.init(MROWS, DIFF_IN, G, bx);
                pg8::EpiQKVRope E{QKV, DIFF_IN, ROPE, attn_body::C2};
                pg8::gemm_phase<pg8::EpiQKVRope, pg8::StaticOrder, PG8_ALIGN, PG8_SP2>(ldsl, g, S, E);
            }
        }
        xcd_barrier(bar);
        if constexpr (l == 0) {
            const int lane = FRESH_LANE();
            for (int row = gw; row < MROWS; row += NGW) {
                const int b = row / TPB, t = row - b * TPB; const bool islat = t >= CTXL; const int pos = t - CTXL;
                unsigned* rp = (unsigned*)(QKV + (size_t)row * PAR_IN + 1536);
#pragma unroll
                for (int j = 0; j < 5; ++j) { const int p = lane + 64 * j, head = p >> 5, i = p & 31; const unsigned w = rp[p];
                    float x1 = bflo(w), x2 = bfhi(w); float ss = x1 * x1 + x2 * x2;
#pragma unroll
                    for (int o = 1; o < 32; o <<= 1) ss += __shfl_xor(ss, o);
                    const float rstd = 1.0f / sqrtf(ss * (1.0f / 64.0f) + EPS); const float* gn = head < 8 ? a.q_gain : a.k_gain;
                    x1 = x1 * rstd * gn[2 * i]; x2 = x2 * rstd * gn[2 * i + 1];
                    if (islat) { const int pp = (i < 16) ? (pos >> 6) : (pos & 63); const float cs = ROPE[(pp * 16 + (i & 15)) * 2], sn = ROPE[(pp * 16 + (i & 15)) * 2 + 1];
                        const float y1 = x1 * cs - x2 * sn, y2 = x1 * sn + x2 * cs; x1 = y1; x2 = y2; }
                    if (head < 8) { x1 *= attn_body::C2; x2 *= attn_body::C2; }
                    rp[p] = pk2(x1, x2); }
            }
            xcd_barrier(bar);
        }
        {
            typedef attn_body::bf16 abf; abf* qkv = (abf*)QKV;
            if constexpr (l == 0) {
                const int pern = (1024 + G - 1) / G;
                for (int i = 0; i < pern; ++i) { const int n = vcu * pern + i; if (n >= 1024) break;
                    const int b = n >> 8, h = (n >> 5) & 7, qb = n & 31; const int r0 = qb * 4; int nb = r0 - 4; nb = nb < 0 ? 0 : (nb > 116 ? 116 : nb);
                    const size_t rb = (size_t)b * TPB, rq = rb + CTXL + (size_t)qb * 256;
                    attn_body::attn_unit<1, 8>(qkv + rq * PAR_IN + h * 64, PAR_IN, qkv + rb * PAR_IN + 512 + h * 64, PAR_IN, qkv + rb * PAR_IN + 1024 + h * 64, PAR_IN,
                                               (abf*)AO + rq * DMODEL + h * 64, DMODEL, 16, nb, r0, (const float*)(ws + WS_MF) + (size_t)h * (15 * 2 * 64 * 16), (char*)lds); }
            }
            if constexpr (l == 0) {
                const int nun = 1024 + 64; const int per = (nun + G - 1) / G;
                for (int i = 0; i < per; ++i) {
                    AttnDesc d; bool ok = true;
                    int g; if (i < 4) g = vcu * 4 + i; else { g = 1024 + vcu; if (vcu >= 64) ok = false; }
                    if (G != 256) { g = i * G + vcu; ok = g < nun; }
                    if (ok && g < 1024) { const int bk = g >> 7, b = bk >> 1, kvh = bk & 1, rem = g & 127, head = kvh * 4 + (rem >> 5), qb = rem & 31;
                        const size_t rb = (size_t)b * TPB, rq = rb + CTXL + (size_t)qb * 256;
                        d.Q = qkv + rq * PAR_IN + 1536 + head * 64; d.K = qkv + rb * PAR_IN + 2048 + kvh * 64; d.V = qkv + rb * PAR_IN + 2176 + kvh * 64; d.O = (abf*)AO + rq * DMODEL + 512 + head * 64;
                        d.PQ = d.PK = d.PV = PAR_IN; d.PO = DMODEL; d.NT = TPB / 64; }
                    else if (ok) { const int u = g - 1024, b = u >> 4, hd = u & 15; const size_t rb = (size_t)b * TPB;
                        if (hd < 8) { d.Q = qkv + rb * PAR_IN + hd * 64; d.K = qkv + rb * PAR_IN + 512 + hd * 64; d.V = qkv + rb * PAR_IN + 1024 + hd * 64; }
                        else { const int gh = hd - 8; d.Q = qkv + rb * PAR_IN + 1536 + gh * 64; d.K = qkv + rb * PAR_IN + 2048 + (gh >> 2) * 64; d.V = qkv + rb * PAR_IN + 2176 + (gh >> 2) * 64; }
                        d.O = (abf*)AO + rb * DMODEL + hd * 64; d.PQ = d.PK = d.PV = PAR_IN; d.PO = DMODEL; d.NT = CTXL / 64; }
                    if (ok) attn_body::attn_unit<0, 8>(d.Q, d.PQ, d.K, d.PK, d.V, d.PV, d.O, d.PO, d.NT, 0, 0, nullptr, (char*)lds);
                }
            } else {
                const int nun = 2048; const int per = (nun + G - 1) / G;
                const float lam = expf(wave_sum(a.lq1[FRESH_LANE()] * a.lk1[FRESH_LANE()])) - expf(wave_sum(a.lq2[FRESH_LANE()] * a.lk2[FRESH_LANE()])) + LAMBDA_INIT;
                for (int i = 0; i < per; ++i) {
                    int g; bool ok = true; if (G == 256) g = (((vcu >> 5) * 4 + (i >> 1)) << 6) + (i & 1) * 32 + (vcu & 31); else { g = i * G + vcu; ok = g < nun; }
                    if (ok) { const int bh = g >> 6, b = bh >> 3, h = bh & 7, sub = g & 63, map = sub >> 5, qb = sub & 31;
                        const size_t rb = (size_t)b * TPB, rq = rb + CTXL + (size_t)qb * 256;
                        attn_body::attn_unit<2, 8>(qkv + rq * DIFF_IN + h * 128 + map * 64, DIFF_IN, qkv + rb * DIFF_IN + 1024 + h * 128 + map * 64, DIFF_IN, qkv + rb * DIFF_IN + 2048 + h * 128, DIFF_IN,
                                                   (abf*)OP + ((size_t)b * SEQ + (size_t)qb * 256) * 2048 + map * 1024 + h * 128, 2048, TPB / 64, 0, 0, nullptr, (char*)lds);
                        if (G == 256 && map == 1) {
                            asm volatile("s_waitcnt vmcnt(0)" ::: "memory"); __builtin_amdgcn_fence(__ATOMIC_SEQ_CST, "workgroup");
                            const int lane = FRESH_LANE(), rsub = lane >> 3, ch = lane & 7;
                            const f32x4* gp = (const f32x4*)(a.subln + ch * 16); const f32x4 g0 = gp[0], g1 = gp[1], g2 = gp[2], g3 = gp[3];
                            const float gn[16] = {g0.x, g0.y, g0.z, g0.w, g1.x, g1.y, g1.z, g1.w, g2.x, g2.y, g2.z, g2.w, g3.x, g3.y, g3.z, g3.w};
#pragma unroll
                            for (int it = 0; it < 4; ++it) { const int r = wave * 32 + it * 8 + rsub; const size_t lr = (size_t)b * SEQ + (size_t)qb * 256 + r;
                                const v4u* p1 = (const v4u*)(OP + lr * 2048 + h * 128) + ch * 2; const v4u* p2 = (const v4u*)(OP + lr * 2048 + 1024 + h * 128) + ch * 2;
                                const v4u a0 = p1[0], a1 = p1[1], b0 = p2[0], b1 = p2[1];
                                const unsigned wa[8] = {a0.x, a0.y, a0.z, a0.w, a1.x, a1.y, a1.z, a1.w}, wb[8] = {b0.x, b0.y, b0.z, b0.w, b1.x, b1.y, b1.z, b1.w};
                                float o[16]; float ss = 0.f;
#pragma unroll
                                for (int e = 0; e < 8; ++e) { o[2 * e] = bflo(wa[e]) - lam * bflo(wb[e]); o[2 * e + 1] = bfhi(wa[e]) - lam * bfhi(wb[e]); ss += o[2 * e] * o[2 * e] + o[2 * e + 1] * o[2 * e + 1]; }
                                ss += __shfl_xor(ss, 1); ss += __shfl_xor(ss, 2); ss += __shfl_xor(ss, 4);
                                const float rs = (1.0f - LAMBDA_INIT) / sqrtf(ss * (1.0f / 128.0f) + EPS);
                                unsigned w[8];
#pragma unroll
                                for (int e = 0; e < 8; ++e) w[e] = pk2(o[2 * e] * rs * gn[2 * e], o[2 * e + 1] * rs * gn[2 * e + 1]);
                                v4u* op = (v4u*)(AO + (rq + r) * DMODEL + h * 128) + ch * 2; op[0] = (v4u){w[0], w[1], w[2], w[3]}; op[1] = (v4u){w[4], w[5], w[6], w[7]}; }
                        }
                    }
                }
            }
        }
        xcd_barrier(bar);
        if (l == 1 && G != 256) {
            const int lane = FRESH_LANE();
            const float d1 = wave_sum(a.lq1[lane] * a.lk1[lane]), d2 = wave_sum(a.lq2[lane] * a.lk2[lane]);
            const float lam = expf(d1) - expf(d2) + LAMBDA_INIT;
            const f32x4* gp = (const f32x4*)(a.subln + (lane & 7) * 16); const f32x4 g0 = gp[0], g1 = gp[1], g2 = gp[2], g3 = gp[3];
            const float gn[16] = {g0.x, g0.y, g0.z, g0.w, g1.x, g1.y, g1.z, g1.w, g2.x, g2.y, g2.z, g2.w, g3.x, g3.y, g3.z, g3.w};
            for (int lr = gw; lr < NBATCH * SEQ; lr += NGW) {
                const int b = lr / SEQ, pos = lr - b * SEQ; const size_t row = (size_t)b * TPB + CTXL + pos;
                const v4u* p1 = (const v4u*)(OP + (size_t)lr * 2048) + lane * 2; const v4u* p2 = p1 + 128;
                const v4u a0 = p1[0], a1 = p1[1], b0 = p2[0], b1 = p2[1];
                const unsigned wa[8] = {a0.x, a0.y, a0.z, a0.w, a1.x, a1.y, a1.z, a1.w}, wb[8] = {b0.x, b0.y, b0.z, b0.w, b1.x, b1.y, b1.z, b1.w};
                float o[16]; float ss = 0.f;
#pragma unroll
                for (int e = 0; e < 8; ++e) { o[2 * e] = bflo(wa[e]) - lam * bflo(wb[e]); o[2 * e + 1] = bfhi(wa[e]) - lam * bfhi(wb[e]); ss += o[2 * e] * o[2 * e] + o[2 * e + 1] * o[2 * e + 1]; }
                ss += __shfl_xor(ss, 1); ss += __shfl_xor(ss, 2); ss += __shfl_xor(ss, 4);
                const float rs = (1.0f - LAMBDA_INIT) / sqrtf(ss * (1.0f / 128.0f) + EPS);
                unsigned w[8];
#pragma unroll
                for (int e = 0; e < 8; ++e) w[e] = pk2(o[2 * e] * rs * gn[2 * e], o[2 * e + 1] * rs * gn[2 * e + 1]);
                v4u* op = (v4u*)(AO + row * DMODEL) + lane * 2; op[0] = (v4u){w[0], w[1], w[2], w[3]}; op[1] = (v4u){w[4], w[5], w[6], w[7]};
            }
            xcd_barrier(bar);
        }
        {
            pg8::Gemm g{AO, W_OUT(l), MROWS, DMODEL, DMODEL, DMODEL}; pg8::StaticOrder S; S.init(MROWS, DMODEL, G, bx, 1);
            pg8::EpiRes E{lat, lat_bs, cxs, ctx_bs, X, modl + 2 * DMODEL};
            pg8::gemm_phase<pg8::EpiRes, pg8::StaticOrder, PG8_ALIGN, PG8_SP2>(ldsl, g, S, E);
            if constexpr (l == 0) {
                pg8::Gemm gc{AO, W_OUT(0), MROWS, DMODEL, 256, DMODEL}; pg8::CtxSplitOrder Sc; Sc.init(4, G, bx);
                pg8::EpiPartial Ec{(float*)(ws + WS_PART)};
                pg8::gemm_phase<pg8::EpiPartial, pg8::CtxSplitOrder, PG8_ALIGN, PG8_SP2>(ldsl, gc, Sc, Ec);
            }
        }
        xcd_barrier(bar);
        norm_mod_phase(X + (size_t)CTXL * DMODEL, (long)TPB * DMODEL, l == 0 ? a.ctx : X, l == 0 ? (long)CTXL * DMODEL : (long)TPB * DMODEL, modl, 3 * DMODEL, 4 * DMODEL, XN, last, gw, NGW, l == 0 ? X : nullptr, (const float*)(ws + WS_PART), 4, modl + 2 * DMODEL);
        xcd_barrier(bar);
        {
            pg8::Gemm g{XN, W_GU(l), MROWS, 2 * DFF, DMODEL, DMODEL}; pg8::StaticOrder S; S.init(MROWS, 2 * DFF, G, bx, last);
            pg8::EpiSwiGLU E{HB, DFF};
            pg8::gemm_phase<pg8::EpiSwiGLU, pg8::StaticOrder, PG8_ALIGN, PG8_SP2>(ldsl, g, S, E);
        }
        xcd_barrier(bar);
        {
            pg8::Gemm g{HB, W_DN(l), MROWS, DMODEL, DFF, DFF}; pg8::StaticOrder S; S.init(MROWS, DMODEL, G, bx, 1);
            pg8::EpiRes E{X + (size_t)CTXL * DMODEL, (long)TPB * DMODEL, X, (long)TPB * DMODEL, X, modl + 5 * DMODEL};
            pg8::gemm_phase<pg8::EpiRes, pg8::StaticOrder, PG8_ALIGN, PG8_SP2>(ldsl, g, S, E);
            if constexpr (l == 0) {
                pg8::Gemm gc{HB, W_DN(0), MROWS, DMODEL, 256, DFF}; pg8::CtxSplitOrder Sc; Sc.init(11, G, bx);
                pg8::EpiPartial Ec{(float*)(ws + WS_PART)};
                pg8::gemm_phase<pg8::EpiPartial, pg8::CtxSplitOrder, PG8_ALIGN, PG8_SP2>(ldsl, gc, Sc, Ec);
            }
        }
        xcd_barrier(bar);
    }

__global__ void __launch_bounds__(NTHREADS, 2) fwd_megakernel(Args a) {
    __shared__ __attribute__((aligned(16))) unsigned char lds[LDS_TOTAL];
    cg::grid_group grid = cg::this_grid();
    const int tid = threadIdx.x, lane = tid & 63, wave = __builtin_amdgcn_readfirstlane(tid >> 6);
    const int G = gridDim.x, bx = blockIdx.x;
    const int vcu = (G % 8 == 0) ? (bx % 8) * (G / 8) + bx / 8 : bx;
    const int gw = vcu * NWAVES + wave, NGW = G * NWAVES;
    unsigned char* ws = a.ws;
    float* MOD = (float*)(ws + WS_MOD); float* ROPE = (float*)(ws + WS_ROPE); float* X = (float*)(ws + WS_X);
    bf16* XN = (bf16*)(ws + WS_XN); bf16* QKV = (bf16*)(ws + WS_QKV); bf16* HB = QKV; bf16* AO = XN; bf16* OP = (bf16*)a.out;
    LAS unsigned char* ldsl = (LAS unsigned char*)lds;

    volatile LAS unsigned* bst = (volatile LAS unsigned*)(ldsl + 131072 + 512);
    if (tid < 2) bst[tid] = 0u;
    unsigned* barw = (unsigned*)(ws + WS_CTL);
    if (bx == 0) for (int i = tid; i < XCD_BAR_WORDS; i += NTHREADS) barw[i] = 0u;
    {
        for (int it = bx; it < 192; it += G) {
            LAS float* sl = (LAS float*)ldsl;
            LAS float* part = sl + 5 * 1024;
            for (int i = tid; i < 5 * 1024; i += NTHREADS) { const float cv = (i < 4096) ? a.c[i] : a.c_ctx[i - 4096]; sl[i] = cv / (1.0f + __expf(-cv)); }
            __syncthreads();
            const int l = it / 96, n = (it % 96) * 64 + lane; const float* wp = a.ada_w + (size_t)l * DMODEL * NMOD6 + n;
            float acc[5] = {0.f, 0.f, 0.f, 0.f, 0.f};
#pragma unroll 32
            for (int k = wave * 128; k < wave * 128 + 128; ++k) { const float w = wp[(size_t)k * NMOD6];
#pragma unroll
                for (int s = 0; s < 5; ++s) acc[s] += sl[s * 1024 + k] * w; }
#pragma unroll
            for (int s = 0; s < 5; ++s) part[(wave * 5 + s) * 64 + lane] = acc[s];
            __syncthreads();
            if (tid < 320) { const int s = tid / 64, ln = tid % 64; float t = a.ada_b[l * NMOD6 + (it % 96) * 64 + ln];
#pragma unroll
                for (int w = 0; w < 8; ++w) t += part[(w * 5 + s) * 64 + ln];
                MOD[(size_t)(l * 5 + s) * NMOD6 + (it % 96) * 64 + ln] = t; }
            __syncthreads();
        }
        {
            unsigned* MF = (unsigned*)(ws + WS_MF);
            for (int idx = bx * NTHREADS + tid; idx < 8 * 15 * 2 * 64 * 16; idx += G * NTHREADS) {
                const int w = idx & 15, ln = (idx >> 4) & 63, chalf = (idx >> 10) & 1, rest = idx >> 11, dr = rest % 15, h = rest / 15;
                const int hi = ln >> 5, c = chalf * 32 + (ln & 31); int cs = c - 8; cs = cs < 0 ? 0 : (cs > 48 ? 48 : cs);
                unsigned pr[2];
#pragma unroll
                for (int q = 0; q < 2; ++q) { const int e = 2 * w + q, ee = e & 15, j = (ee & 3) + 8 * (ee >> 2) + 4 * hi + (e >= 16 ? 32 : 0);
                    pr[q] = (j >= cs && j < cs + 16) ? f2bf(a.na_rpb[h * 465 + dr * 31 + (j - c + 15)] * 1.4426950408889634f) : 0xff80u; }
                MF[idx] = pr[0] | (pr[1] << 16);
            }
        }
        if (bx == G - 1) {
            for (int i = tid; i < 128 * 16; i += NTHREADS) { const int pos = i / 16, f = i % 16; const float inv = powf(10000.0f, -(float)f / 16.0f); const float ang = (float)pos * inv;
                ROPE[2 * i] = cosf(ang); ROPE[2 * i + 1] = sinf(ang); }
        }
        __syncthreads();
        LAS float* scr = (LAS float*)(ldsl + wave * 16384);
        constexpr int NITEMS = 16 * (PAR_IN / 32) + 16 * (DIFF_IN / 32) + 2 * (16 * 32 + 2 * 16 * (DFF / 32) + (DFF / 64) * 32);
        for (int it = gw; it < NITEMS; it += NGW) {
            int r = it;
            if (transpose_mat(r, a.par_w_in, DMODEL, PAR_IN, W_IN(0), 0, scr, lane)) continue;
            if (transpose_mat(r, a.par_w_out, DMODEL, DMODEL, W_OUT(0), 0, scr, lane)) continue;
            if (transpose_mat(r, a.w_gate, DMODEL, DFF, W_GU(0), 1, scr, lane)) continue;
            if (transpose_mat(r, a.w_up, DMODEL, DFF, W_GU(0), 2, scr, lane)) continue;
            if (transpose_mat(r, a.w_down, DFF, DMODEL, W_DN(0), 0, scr, lane)) continue;
            if (transpose_mat(r, a.diff_w_in, DMODEL, DIFF_IN, W_IN(1), 0, scr, lane)) continue;
            if (transpose_mat(r, a.diff_w_out, DMODEL, DMODEL, W_OUT(1), 0, scr, lane)) continue;
            if (transpose_mat(r, a.w_gate + (size_t)DMODEL * DFF, DMODEL, DFF, W_GU(1), 1, scr, lane)) continue;
            if (transpose_mat(r, a.w_up + (size_t)DMODEL * DFF, DMODEL, DFF, W_GU(1), 2, scr, lane)) continue;
            transpose_mat(r, a.w_down + (size_t)DFF * DMODEL, DFF, DMODEL, W_DN(1), 0, scr, lane);
        }
    }
    grid.sync();
    const XcdBarrier bar = xcd_barrier_post(barw, bst);

    layer_body<0>(a, lds, bar, G, bx, vcu, gw, NGW, lane, tid, wave);
    layer_body<1>(a, lds, bar, G, bx, vcu, gw, NGW, lane, tid, wave);
    { const int lane = FRESH_LANE();
    f32x4 vn[4];
    { const int b = gw / SEQ, pos = gw - b * SEQ; const f32x4* xr = (const f32x4*)(X + ((size_t)b * TPB + CTXL + pos) * DMODEL) + lane;
#pragma unroll
        for (int j = 0; j < 4; ++j) vn[j] = xr[64 * j]; }
    for (int lr = gw; lr < NBATCH * SEQ; lr += NGW) {
        f32x4 v[4]; float ss = 0.f;
#pragma unroll
        for (int j = 0; j < 4; ++j) v[j] = vn[j];
        if (lr + NGW < NBATCH * SEQ) { const int ln = lr + NGW, b = ln / SEQ, pos = ln - b * SEQ; const f32x4* xr = (const f32x4*)(X + ((size_t)b * TPB + CTXL + pos) * DMODEL) + lane;
#pragma unroll
            for (int j = 0; j < 4; ++j) vn[j] = xr[64 * j]; }
#pragma unroll
        for (int j = 0; j < 4; ++j) ss += (v[j].x * v[j].x + v[j].y * v[j].y) + (v[j].z * v[j].z + v[j].w * v[j].w);
        const float rstd = 1.0f / sqrtf(wave_sum(ss) * (1.0f / DMODEL) + EPS);
        const f32x4* gp = (const f32x4*)a.fgain + lane; f32x4* op = (f32x4*)(a.out + (size_t)lr * DMODEL) + lane;
#pragma unroll
        for (int j = 0; j < 4; ++j) op[64 * j] = v[j] * rstd * gp[64 * j];
    } }
}

extern "C" void kernel_launch(void* const* d_in, const int* in_sizes, int n_in, void* d_out, int out_size, void* d_ws, size_t ws_size, hipStream_t stream) {
    static int grid = 0;
    if (grid == 0) {
        if (n_in != 22 || in_sizes[0] != NBATCH * SEQ * DMODEL || out_size != NBATCH * SEQ * DMODEL || ws_size < WS_MF + (size_t)8 * 15 * 2 * 64 * 16 * 4) { fprintf(stderr, "kernel_launch: unexpected problem shape (n_in %d, ws %zu)\n", n_in, ws_size); grid = -1; return; }
        int dev = 0, cus = 0, per_cu = 0;
        hipGetDevice(&dev); hipDeviceGetAttribute(&cus, hipDeviceAttributeMultiprocessorCount, dev);
        hipOccupancyMaxActiveBlocksPerMultiprocessor(&per_cu, (const void*)fwd_megakernel, NTHREADS, 0);
        if (per_cu < 1) { fprintf(stderr, "kernel_launch: occupancy query says %d blocks per CU\n", per_cu); per_cu = 1; }
        (void)hipGetLastError();
        grid = cus;
    }
    if (grid < 0) return;
    Args a{};
    const float** ap = (const float**)&a;
    for (int i = 0; i < 22; ++i) ap[i] = (const float*)d_in[i];
    a.out = (float*)d_out; a.ws = (unsigned char*)d_ws;
    void* args[] = {&a};
    hipError_t e = hipLaunchCooperativeKernel((const void*)fwd_megakernel, dim3(grid), dim3(NTHREADS), args, 0, stream);
    if (e != hipSuccess) fprintf(stderr, "cooperative launch failed: %s (grid %d)\n", hipGetErrorString(e), grid);
}
```

```cpp
#include <hip/hip_runtime.h>
#include <hip/hip_cooperative_groups.h>
#include <cstdio>
#include <cstdint>
namespace cg = cooperative_groups;
namespace pg8 {
#define PG8_LAS __attribute__((address_space(3)))
typedef unsigned short bf16_t;
typedef short bf16x8 __attribute__((ext_vector_type(8)));
typedef float f32x4 __attribute__((ext_vector_type(4)));
typedef unsigned u32x4 __attribute__((ext_vector_type(4)));
constexpr int BM = 256, BK = 64, HALF = 128, HTB = HALF * BK * 2  , STAGE_BYTES = 8 * HTB, NXCD = 8, WGM = 8;

__host__ __device__ __forceinline__ int lds_byte(int r, int c) { const int st = (r >> 4) * 2 + (c >> 5), rr = r & 15, cc = c & 31, ob = rr * 64 + cc * 2; return st * 1024 + (ob ^ (((ob >> 9) & 1) << 5)); }
__host__ __device__ __forceinline__ void stage_rc(int b, int& R, int& C) { const int st = b / 1024, sb = b % 1024, swz = sb ^ (((sb >> 9) & 1) << 5); R = (st >> 1) * 16 + swz / 64; C = (st & 1) * 32 + (swz % 64) / 2; }
__host__ __device__ __forceinline__ int perm32(int rho) { const int n = rho >> 4, i = rho & 15; return 8 * (i >> 2) + 4 * n + (i & 3); }

struct Unit { int pm, pn, kc; };
struct Gemm { const bf16_t* A; const bf16_t* Bt; int M, N, K, ld; };

struct StaticOrder {
    static constexpr bool OPAQUE_NT = false;
    int nM, nN, nwg, G, c, skip;
    __host__ __device__ void init(int M, int N, int G_, int c_, int skip_ = 0) { skip = skip_; nM = skip ? 128 : M / BM; nN = N / BM; nwg = nM * nN; G = G_; c = c_; }
    __host__ __device__ bool next(int i, Unit& u) const {
        const long L = (long)i * G + c; if (L >= nwg) return false;
        int wgid = (int)L; { const int q = nwg / NXCD, r = nwg % NXCD, xcd = wgid % NXCD, off = wgid / NXCD; wgid = (xcd < r ? xcd * (q + 1) : r * (q + 1) + (xcd - r) * q) + off; }
        const int nig = WGM * nN, gid = wgid / nig, fm = gid * WGM, gsz = (nM - fm) < WGM ? (nM - fm) : WGM;
        u.pm = fm + ((wgid % nig) % gsz); u.pn = (wgid % nig) / gsz; u.kc = 0; if (skip) u.pm += u.pm / 32 + 1; return true;
    }
    __device__ __forceinline__ void a_ready(const Unit&) const {}
    __device__ __forceinline__ void done(const Unit&) const {}
};

struct CtxSplitOrder {
    static constexpr bool OPAQUE_NT = true;
    int nkc, G, c;
    __host__ __device__ void init(int nkc_, int G_, int c_) { nkc = nkc_; G = G_; c = c_; }
    __host__ __device__ bool next(int i, Unit& u) const { const int L = i * G + c; if (L >= 16 * nkc) return false; u.kc = L % nkc; const int t = L / nkc; u.pn = t & 3; u.pm = 33 * (t >> 2); return true; }
    __device__ __forceinline__ void a_ready(const Unit&) const {}
    __device__ __forceinline__ void done(const Unit&) const {}
};
__device__ __forceinline__ unsigned cvt_pk_bf16(float lo, float hi) { unsigned r; asm volatile("v_cvt_pk_bf16_f32 %0, %1, %2" : "=v"(r) : "v"(lo), "v"(hi)); return r; }
typedef float f32x2 __attribute__((ext_vector_type(2)));
__device__ __forceinline__ f32x2 gelu_pk(f32x2 v) {
    const f32x2 av = __builtin_elementwise_abs(v), d = av * 0.2316418882f + 1.0f;
    f32x2 t; t.x = __builtin_amdgcn_rcpf(d.x); t.y = __builtin_amdgcn_rcpf(d.y);
    f32x2 q = t * 0.5307027145f + (-0.7265760135f); q = q * t + 0.7107068705f; q = q * t + (-0.142248368f); q = q * t + 0.127414796f; q = q * t;
    const f32x2 s = (v * v) * (-0.72134752044f);
    f32x2 e; e.x = __builtin_amdgcn_exp2f(s.x); e.y = __builtin_amdgcn_exp2f(s.y);
    const f32x2 m = v * (q * e), r = v - m;
    f32x2 o; o.x = v.x < 0.f ? m.x : r.x; o.y = v.y < 0.f ? m.y : r.y; return o;
}

template <int ACT  > struct EpiBf16 {
    static constexpr bool PERM = true, AFTER_DRAIN = false; static_assert(ACT == 0 || ACT == 1, "EpiBf16: ACT is 0 (none) or 1 (gelu_pk)");
    bf16_t* O; int ldc; const float* bias; int split_cols; size_t split_stride; float scale0;
    __device__ __forceinline__ void operator()(const f32x4 (&acc)[2][2][4][2], const Unit& u, int wr, int wc, int fr, int fq) const {
        const int row0 = u.pm * BM + wr * 64 + fr; int colt = u.pn * BM; bf16_t* base = O;
        float sc = 1.f; if (split_cols) { const int t = colt / split_cols; base += (size_t)t * split_stride; colt -= t * split_cols; if (t == 0) sc = scale0; }
        const int col0 = colt + wc * 32 + 8 * fq, bcol0 = u.pn * BM + wc * 32 + 8 * fq;
        f32x4 bv[2][2];
#pragma unroll
        for (int bj = 0; bj < 2; ++bj)
#pragma unroll
            for (int n = 0; n < 2; ++n) bv[bj][n] = bias ? *(const f32x4*)(bias + bcol0 + bj * HALF + 4 * n) : (f32x4){0.f, 0.f, 0.f, 0.f};
#pragma unroll
        for (int ai = 0; ai < 2; ++ai)
#pragma unroll
            for (int m = 0; m < 4; ++m) { bf16_t* rowp = base + (size_t)(row0 + ai * HALF + m * 16) * ldc + col0;
#pragma unroll
                for (int bj = 0; bj < 2; ++bj) { f32x4 v0 = acc[ai][bj][m][0] + bv[bj][0], v1 = acc[ai][bj][m][1] + bv[bj][1];
                    if (ACT == 1) { f32x2 a = gelu_pk((f32x2){v0[0], v0[1]}), b = gelu_pk((f32x2){v0[2], v0[3]}), c = gelu_pk((f32x2){v1[0], v1[1]}), d = gelu_pk((f32x2){v1[2], v1[3]});
                        v0 = (f32x4){a.x, a.y, b.x, b.y}; v1 = (f32x4){c.x, c.y, d.x, d.y}; }
                    v0 = v0 * sc; v1 = v1 * sc; u32x4 w; w.x = cvt_pk_bf16(v0[0], v0[1]); w.y = cvt_pk_bf16(v0[2], v0[3]); w.z = cvt_pk_bf16(v1[0], v1[1]); w.w = cvt_pk_bf16(v1[2], v1[3]);
                    *(u32x4*)(rowp + bj * HALF) = w; } }
    }
};
struct EpiRes {
    static constexpr bool PERM = false, AFTER_DRAIN = false;
    const float* base_lat; long lat_bs; const float* base_ctx; long ctx_bs; float* out; const float* gate;
    __device__ __forceinline__ void operator()(const f32x4 (&acc)[2][2][4][2], const Unit& u, int wr, int wc, int fr, int fq) const {
        const int b = u.pm / 33, tt = u.pm - b * 33; const bool isctx = (tt == 0);
        const float* g = gate + (isctx ? 4 : b) * 6144;
        const float* src = isctx ? base_ctx + (size_t)b * ctx_bs : base_lat + (size_t)b * lat_bs + (size_t)(tt * 256 - 256) * 1024;
        float* dst = out + (size_t)u.pm * 256 * 1024;
        const int col0 = u.pn * BM + wc * 32 + 4 * fq;
        const size_t off0 = (size_t)(wr * 64 + fr) * 1024 + col0;
#pragma unroll
        for (int bj = 0; bj < 2; ++bj)
#pragma unroll
            for (int n = 0; n < 2; ++n) { const f32x4 gv = *(const f32x4*)(g + col0 + bj * HALF + n * 16); f32x4 bs[2][4];
#pragma unroll
                for (int ai = 0; ai < 2; ++ai)
#pragma unroll
                    for (int m = 0; m < 4; ++m) bs[ai][m] = *(const f32x4*)(src + off0 + (size_t)(ai * HALF + m * 16) * 1024 + bj * HALF + n * 16);
#pragma unroll
                for (int ai = 0; ai < 2; ++ai)
#pragma unroll
                    for (int m = 0; m < 4; ++m) *(f32x4*)(dst + off0 + (size_t)(ai * HALF + m * 16) * 1024 + bj * HALF + n * 16) = bs[ai][m] + gv * acc[ai][bj][m][n];
                asm volatile("" ::: "memory"); }
    }
};
struct EpiSwiGLU {
    static constexpr bool PERM = true, AFTER_DRAIN = false;
    bf16_t* H; int ldh;
    __device__ __forceinline__ void operator()(const f32x4 (&acc)[2][2][4][2], const Unit& u, int wr, int wc, int fr, int fq) const {
        const int row0 = u.pm * BM + wr * 64 + fr, col0 = u.pn * HALF + wc * 32 + 8 * fq;
#pragma unroll
        for (int ai = 0; ai < 2; ++ai)
#pragma unroll
            for (int m = 0; m < 4; ++m) { bf16_t* rowp = H + (size_t)(row0 + ai * HALF + m * 16) * ldh + col0; float hv[8];
#pragma unroll
                for (int n = 0; n < 2; ++n)
#pragma unroll
                    for (int e = 0; e < 4; ++e) { const float g = acc[ai][0][m][n][e], up = acc[ai][1][m][n][e]; hv[n * 4 + e] = g * __builtin_amdgcn_rcpf(1.0f + __expf(-g)) * up; }
                u32x4 w; w.x = cvt_pk_bf16(hv[0], hv[1]); w.y = cvt_pk_bf16(hv[2], hv[3]); w.z = cvt_pk_bf16(hv[4], hv[5]); w.w = cvt_pk_bf16(hv[6], hv[7]);
                *(u32x4*)rowp = w; }
    }
};
struct EpiQKVRope {
    static constexpr bool PERM = true, AFTER_DRAIN = false;
    bf16_t* O; int ldc; const float* rope; float qscale;
    __device__ __forceinline__ void operator()(const f32x4 (&acc)[2][2][4][2], const Unit& u, int wr, int wc, int fr, int fq) const {
        const int b = u.pm / 33, tt = u.pm - b * 33; const bool dorope = (tt != 0) && (u.pn < 8); const float sc = (u.pn < 4) ? qscale : 1.0f;
        const int rl = wr * 64 + fr, col0 = u.pn * BM + wc * 32 + 8 * fq, i0 = (wc & 1) * 16 + 4 * fq;
#pragma unroll
        for (int ai = 0; ai < 2; ++ai)
#pragma unroll
            for (int m = 0; m < 4; ++m) { const int r = rl + ai * HALF + m * 16; bf16_t* rowp = O + (size_t)(u.pm * BM + r) * ldc + col0;
                f32x4 t0 = (f32x4){1.f, 0.f, 1.f, 0.f}, t1 = t0;
                if (dorope) { const int pos = tt * 256 - 256 + r; const int pp = (i0 < 16) ? (pos >> 6) : (pos & 63); const f32x4* tb = (const f32x4*)(rope + (pp * 16 + (i0 & 15)) * 2); t0 = tb[0]; t1 = tb[1]; }
#pragma unroll
                for (int bj = 0; bj < 2; ++bj) { const f32x4 v0 = acc[ai][bj][m][0], v1 = acc[ai][bj][m][1]; u32x4 w;
                    w.x = cvt_pk_bf16((v0[0] * t0[0] - v0[1] * t0[1]) * sc, (v0[0] * t0[1] + v0[1] * t0[0]) * sc);
                    w.y = cvt_pk_bf16((v0[2] * t0[2] - v0[3] * t0[3]) * sc, (v0[2] * t0[3] + v0[3] * t0[2]) * sc);
                    w.z = cvt_pk_bf16((v1[0] * t1[0] - v1[1] * t1[1]) * sc, (v1[0] * t1[1] + v1[1] * t1[0]) * sc);
                    w.w = cvt_pk_bf16((v1[2] * t1[2] - v1[3] * t1[3]) * sc, (v1[2] * t1[3] + v1[3] * t1[2]) * sc);
                    *(u32x4*)(rowp + bj * HALF) = w; } }
    }
};
struct EpiPartial {
    static constexpr bool PERM = false, AFTER_DRAIN = false;
    float* P;
    __device__ __forceinline__ void operator()(const f32x4 (&acc)[2][2][4][2], const Unit& u, int wr, int wc, int fr, int fq) const {
        const int col0 = u.pn * BM + wc * 32 + 4 * fq;
        float* dst = P + ((size_t)u.kc * 1024 + (u.pm / 33) * 256 + wr * 64 + fr) * 1024 + col0;
#pragma unroll
        for (int ai = 0; ai < 2; ++ai)
#pragma unroll
            for (int m = 0; m < 4; ++m) { float* p = dst + (size_t)(ai * HALF + m * 16) * 1024;
#pragma unroll
                for (int bj = 0; bj < 2; ++bj)
#pragma unroll
                    for (int n = 0; n < 2; ++n) *(f32x4*)(p + bj * HALF + n * 16) = acc[ai][bj][m][n];
                asm volatile("" ::: "memory"); }
    }
};
template <class Epi, class Sched, bool ALIGN_EPI = false, bool SP2 = false>
__device__ __forceinline__ void gemm_phase(PG8_LAS unsigned char* lds, const Gemm g, const Sched& S, const Epi& E) {
    int tid_ = threadIdx.x; asm volatile("" : "+v"(tid_));
    const int tid = tid_, wid = __builtin_amdgcn_readfirstlane(tid >> 6), lane = tid & 63, wr = wid >> 2, wc = wid & 3, fr = lane & 15, fq = lane >> 4;
    const int K = g.K, ld = g.ld; int nt_ = K / BK; if constexpr (Sched::OPAQUE_NT) asm volatile("" : "+s"(nt_));
    const int nt = nt_;
    unsigned voffA[2], voffB[2];
#pragma unroll
    for (int i = 0; i < 2; ++i) { int R, C; stage_rc(tid * 16 + i * 8192, R, C); const int Rb = Epi::PERM ? ((R & ~31) + perm32(R & 31)) : R;
        voffA[i] = (unsigned)(R * ld + C) * 2u; voffB[i] = (unsigned)(Rb * ld + C) * 2u; }
    const size_t kstep = (size_t)(BK * 2);
    const size_t hstep = (size_t)HALF * ld * 2;
    const size_t tstep = 2 * hstep;
    const unsigned ldsw = (unsigned)wid * 1024u;
    const int aoff = lds_byte(wr * 64 + fr, fq * 8), boff = lds_byte(wc * 32 + fr, fq * 8);
#define PG8_SA(b, h) (((b) * 2 + (h)) * HTB)
#define PG8_SB(b, h) ((4 + (b) * 2 + (h)) * HTB)
#define PG8_STAGE(bufoff, gbase, voff) do { _Pragma("unroll") for (int _i = 0; _i < 2; ++_i) \
        __builtin_amdgcn_global_load_lds((const unsigned*)((const char*)(gbase) + (voff)[_i]), (PG8_LAS unsigned*)(lds + (bufoff) + ldsw + _i * 8192), 16, 0, 0); } while (0)
#define PG8_LDA(dst, b, h) do { _Pragma("unroll") for (int m = 0; m < 4; ++m) _Pragma("unroll") for (int k = 0; k < 2; ++k) dst[m][k] = *(const PG8_LAS bf16x8*)(lds + PG8_SA(b, h) + aoff + m * 2048 + k * 1024); } while (0)
#define PG8_LDB(dst, b, h) do { _Pragma("unroll") for (int n = 0; n < 2; ++n) _Pragma("unroll") for (int k = 0; k < 2; ++k) dst[n][k] = *(const PG8_LAS bf16x8*)(lds + PG8_SB(b, h) + boff + n * 2048 + k * 1024); } while (0)
#define PG8_MMA(ai, bj, At, Bt) do { __builtin_amdgcn_s_setprio(1); _Pragma("unroll") for (int m = 0; m < 4; ++m) _Pragma("unroll") for (int n = 0; n < 2; ++n) _Pragma("unroll") for (int k = 0; k < 2; ++k) \
        acc[ai][bj][m][n] = __builtin_amdgcn_mfma_f32_16x16x32_bf16(Bt[n][k], At[m][k], acc[ai][bj][m][n], 0, 0, 0); __builtin_amdgcn_s_setprio(0); } while (0)
#define PG8_WAIT_V(n) asm volatile("s_waitcnt vmcnt(" #n ")" ::: "memory")
#define PG8_WAIT_L(n) asm volatile("s_waitcnt lgkmcnt(" #n ")" ::: "memory")
#define PG8_BAR __builtin_amdgcn_s_barrier()
#define PG8_SCHED __builtin_amdgcn_sched_barrier(0)
    Unit cur, nxt; int ui = 0;
    if (!S.next(0, cur)) return;
    f32x4 acc[2][2][4][2];
#pragma unroll
    for (int a = 0; a < 2; ++a)
#pragma unroll
        for (int b = 0; b < 2; ++b)
#pragma unroll
            for (int m = 0; m < 4; ++m)
#pragma unroll
                for (int n = 0; n < 2; ++n) acc[a][b][m][n] = (f32x4){0.f, 0.f, 0.f, 0.f};
    bf16x8 At[4][2], B0[2][2], B1[2][2];
    const size_t cstep = (size_t)K * 2;
    const char* cA = (const char*)g.A + (size_t)cur.pm * tstep + (size_t)cur.kc * cstep; const char* cB = (const char*)g.Bt + (size_t)cur.pn * tstep + (size_t)cur.kc * cstep;
    S.a_ready(cur);
    if constexpr (SP2) {
        PG8_STAGE(PG8_SB(0, 0), cB, voffB); PG8_STAGE(PG8_SB(0, 1), cB + hstep, voffB); PG8_STAGE(PG8_SA(0, 0), cA, voffA); PG8_STAGE(PG8_SA(0, 1), cA + hstep, voffA);
        if (wr == 1) PG8_BAR;
        PG8_WAIT_V(2); PG8_BAR;
        PG8_STAGE(PG8_SB(1, 0), cB + kstep, voffB); PG8_STAGE(PG8_SA(1, 0), cA + kstep, voffA); PG8_STAGE(PG8_SB(1, 1), cB + hstep + kstep, voffB);
        PG8_WAIT_V(6); PG8_BAR;
    } else {
        PG8_STAGE(PG8_SB(0, 0), cB, voffB); PG8_STAGE(PG8_SA(0, 0), cA, voffA); PG8_STAGE(PG8_SB(0, 1), cB + hstep, voffB); PG8_STAGE(PG8_SA(0, 1), cA + hstep, voffA);
        if (wr == 1) PG8_BAR;
        PG8_WAIT_V(4); PG8_BAR;
        PG8_STAGE(PG8_SB(1, 0), cB + kstep, voffB); PG8_STAGE(PG8_SA(1, 0), cA + kstep, voffA); PG8_STAGE(PG8_SB(1, 1), cB + hstep + kstep, voffB);
        PG8_WAIT_V(6); PG8_BAR;
    }
    for (;;) {
        const bool has_next = S.next(ui + 1, nxt);
        const char* nA = has_next ? (const char*)g.A + (size_t)nxt.pm * tstep + (size_t)nxt.kc * cstep : cA; const char* nB = has_next ? (const char*)g.Bt + (size_t)nxt.pn * tstep + (size_t)nxt.kc * cstep : cB;
        for (int t = 0; t < nt; t += 2) {
            const bool last = (t == nt - 2);
            const char* a1 = cA + (size_t)(t + 1) * kstep;
            const char* a2 = last ? nA : cA + (size_t)(t + 2) * kstep; const char* b2 = last ? nB : cB + (size_t)(t + 2) * kstep;
            const char* a3 = a2 + kstep; const char* b3 = b2 + kstep;
            if (last && has_next) S.a_ready(nxt);
            if constexpr (SP2) {
            PG8_LDB(B0, 0, 0); PG8_LDB(B1, 0, 1); PG8_SCHED; PG8_LDA(At, 0, 0); PG8_STAGE(PG8_SA(1, 1), a1 + hstep, voffA);
            PG8_WAIT_V(8); PG8_WAIT_L(0); PG8_BAR; PG8_MMA(0, 0, At, B0); PG8_MMA(0, 1, At, B1); PG8_BAR; PG8_SCHED;
            PG8_LDA(At, 0, 1); PG8_STAGE(PG8_SB(0, 0), b2, voffB); PG8_STAGE(PG8_SB(0, 1), b2 + hstep, voffB); PG8_STAGE(PG8_SA(0, 0), a2, voffA);
            PG8_WAIT_V(8); PG8_WAIT_L(0); PG8_BAR; PG8_MMA(1, 0, At, B0); PG8_MMA(1, 1, At, B1); PG8_BAR; PG8_SCHED;
            PG8_LDB(B0, 1, 0); PG8_LDB(B1, 1, 1); PG8_SCHED; PG8_LDA(At, 1, 0); PG8_STAGE(PG8_SA(0, 1), a2 + hstep, voffA);
            PG8_WAIT_V(8); PG8_WAIT_L(0); PG8_BAR; PG8_MMA(0, 0, At, B0); PG8_MMA(0, 1, At, B1); PG8_BAR; PG8_SCHED;
            PG8_LDA(At, 1, 1); PG8_STAGE(PG8_SB(1, 0), b3, voffB); PG8_STAGE(PG8_SB(1, 1), b3 + hstep, voffB); PG8_STAGE(PG8_SA(1, 0), a3, voffA);
            PG8_WAIT_V(8); PG8_WAIT_L(0); PG8_BAR; PG8_MMA(1, 0, At, B0); PG8_MMA(1, 1, At, B1); PG8_BAR; PG8_SCHED;
            } else {
            PG8_LDB(B0, 0, 0); PG8_SCHED; PG8_LDA(At, 0, 0); PG8_STAGE(PG8_SA(1, 1), a1 + hstep, voffA);
            PG8_WAIT_L(8); PG8_BAR; PG8_WAIT_L(0); PG8_MMA(0, 0, At, B0); PG8_BAR; PG8_SCHED;
            PG8_LDB(B1, 0, 1); PG8_STAGE(PG8_SB(0, 0), b2, voffB);
            PG8_BAR; PG8_WAIT_L(0); PG8_MMA(0, 1, At, B1); PG8_BAR;
            PG8_LDA(At, 0, 1); PG8_STAGE(PG8_SA(0, 0), a2, voffA);
            PG8_BAR; PG8_WAIT_L(0); PG8_MMA(1, 0, At, B0); PG8_BAR; PG8_SCHED;
            PG8_STAGE(PG8_SB(0, 1), b2 + hstep, voffB);
            PG8_WAIT_V(6); PG8_BAR; PG8_MMA(1, 1, At, B1); PG8_BAR;
            PG8_LDB(B0, 1, 0); PG8_SCHED; PG8_LDA(At, 1, 0); PG8_STAGE(PG8_SA(0, 1), a2 + hstep, voffA);
            PG8_WAIT_L(8); PG8_BAR; PG8_WAIT_L(0); PG8_MMA(0, 0, At, B0); PG8_BAR; PG8_SCHED;
            PG8_LDB(B1, 1, 1); PG8_STAGE(PG8_SB(1, 0), b3, voffB);
            PG8_BAR; PG8_WAIT_L(0); PG8_MMA(0, 1, At, B1); PG8_BAR;
            PG8_LDA(At, 1, 1); PG8_STAGE(PG8_SA(1, 0), a3, voffA);
            PG8_BAR; PG8_WAIT_L(0); PG8_MMA(1, 0, At, B0); PG8_BAR; PG8_SCHED;
            PG8_STAGE(PG8_SB(1, 1), b3 + hstep, voffB);
            PG8_WAIT_V(6); PG8_BAR; PG8_MMA(1, 1, At, B1); PG8_BAR;
            }
        }
        if constexpr (ALIGN_EPI) { if (wr == 0) PG8_BAR; }
        if constexpr (!Epi::AFTER_DRAIN) { E(acc, cur, wr, wc, fr, fq); S.done(cur); }
        if (!has_next) break;
#pragma unroll
        for (int a = 0; a < 2; ++a)
#pragma unroll
            for (int b = 0; b < 2; ++b)
#pragma unroll
                for (int m = 0; m < 4; ++m)
#pragma unroll
                    for (int n = 0; n < 2; ++n) acc[a][b][m][n] = (f32x4){0.f, 0.f, 0.f, 0.f};
        cur = nxt; cA = nA; cB = nB; ++ui;
        if constexpr (ALIGN_EPI) { if (wr == 1) PG8_BAR; }
    }
    PG8_WAIT_V(0);
    if constexpr (!ALIGN_EPI) { if (wr == 0) PG8_BAR; }
    PG8_BAR;
    if constexpr (Epi::AFTER_DRAIN) { E.fused(acc, cur, wr, wc, fr, fq, lds, wid, lane); S.done(cur); }
#undef PG8_SA
#undef PG8_SB
#undef PG8_STAGE
#undef PG8_LDA
#undef PG8_LDB
#undef PG8_MMA
#undef PG8_WAIT_V
#undef PG8_WAIT_L
#undef PG8_BAR
#undef PG8_SCHED
}
}

#ifndef PG8_SP2
#define PG8_SP2 true
#endif
#ifndef PG8_ALIGN
#define PG8_ALIGN true
#endif
#include <hip/hip_bf16.h>
#include <cmath>
namespace attn_body {
using bf16=__hip_bfloat16;
using bf16x8=__attribute__((ext_vector_type(8)))short;
using s16x4=__attribute__((ext_vector_type(4)))short;
using f32x16=__attribute__((ext_vector_type(16)))float;
using u32x4=__attribute__((ext_vector_type(4)))unsigned;
constexpr int D=64;
constexpr int NW=8,QBLK=32,QB=QBLK*NW,KVBLK=64;
constexpr int ATTN_UNIT_ROWS=QB;
__device__ __forceinline__ int crow(int r,int hi){return (r&3)+8*(r>>2)+4*hi;}
#define SBAR() __builtin_amdgcn_sched_barrier(0)
typedef __attribute__((address_space(3))) const float* lds_cfptr;
__device__ __forceinline__ void namask(f32x16&p0,f32x16&p1,int t,int nabase,int r,int c,int hi,lds_cfptr tb){
  const float NEG=-INFINITY; const int kr=nabase+t-4; int rs=r-4; rs=rs<0?0:(rs>120?120:rs);
  if(kr<rs||kr>=rs+8){
    #pragma unroll
    for(int rr=0;rr<16;++rr){p0[rr]=NEG;p1[rr]=NEG;}
    return; }
  int cs=c-8; cs=cs<0?0:(cs>48?48:cs);
  const int rowi=(kr-r+7)*31+15-c;
  #pragma unroll
  for(int rr=0;rr<16;++rr){ const int j=(rr&3)+8*(rr>>2)+4*hi, j1=j+32;
    const bool v0=(j>=cs)&&(j<cs+16), v1=(j1>=cs)&&(j1<cs+16);
    const float b0=tb[v0?rowi+j:0], b1=tb[v1?rowi+j1:0];
    p0[rr]=v0?p0[rr]+b0:NEG; p1[rr]=v1?p1[rr]+b1:NEG; }
}

typedef unsigned u32x4_t __attribute__((ext_vector_type(4)));
__device__ __forceinline__ bool na_rowok(int t,int nabase,int r){ const int kr=nabase+t-4; int rs=r-4; rs=rs<0?0:(rs>120?120:rs); return kr>=rs&&kr<rs+8; }
__device__ __forceinline__ void na_mfload(u32x4_t*mf,const unsigned*mfh,int t,int nabase,int r,int chalf,int lane){
  const int dr=nabase+t-4-r+7; const u32x4_t*p=(const u32x4_t*)(mfh+(size_t)(((dr*2+chalf)*64+lane)*16));
  #pragma unroll
  for(int i=0;i<4;++i)mf[i]=p[i];
}
__device__ __forceinline__ void na_apply(f32x16&p0,f32x16&p1,const u32x4_t*mf,bool ok){
  if(!ok){ const float NEG=-INFINITY;
    #pragma unroll
    for(int rr=0;rr<16;++rr){p0[rr]=NEG;p1[rr]=NEG;}
    return; }
  #pragma unroll
  for(int rr=0;rr<16;++rr){ const unsigned w0=mf[rr>>3][(rr>>1)&3], w1=mf[2+(rr>>3)][(rr>>1)&3];
    p0[rr]+=__builtin_bit_cast(float,(rr&1)?(w0&0xffff0000u):(w0<<16)); p1[rr]+=__builtin_bit_cast(float,(rr&1)?(w1&0xffff0000u):(w1<<16)); }
}

constexpr int NSLOT=3, SLOTB=8192, VSLOTB=2*SLOTB;
constexpr int LDS_K=0, LDS_V=NSLOT*SLOTB, LDS_WS=LDS_V+NSLOT*VSLOTB, LDS_OST=LDS_WS+NW*64*4, LDS_TB=LDS_OST+NW*4096, LDS_BYTES=LDS_TB+2048;
constexpr float C2=0.125f*1.4426950408889634f;
__device__ __forceinline__ void glds16(const void*gsrc,unsigned lds_dst){unsigned keep;
  asm volatile("s_mov_b32 %0, m0\n\ts_mov_b32 m0, %2\n\ts_nop 0\n\tglobal_load_lds_dwordx4 %1, off\n\ts_mov_b32 m0, %0":"=&s"(keep):"v"(gsrc),"s"(lds_dst):"memory");}
__device__ __forceinline__ float max3f(float a,float b,float c){float r;asm("v_max3_f32 %0, %1, %2, %3":"=v"(r):"v"(a),"v"(b),"v"(c));return r;}
__device__ __forceinline__ float max2f(float a,float b){float r;asm("v_max_f32_e32 %0, %1, %2":"=v"(r):"v"(a),"v"(b));return r;}
__device__ __forceinline__ float fadd_s(float a,float b){float r;asm("v_add_f32_e32 %0, %1, %2":"=v"(r):"v"(a),"v"(b));return r;}
__device__ __forceinline__ float fsub_s(float a,float b){float r;asm("v_sub_f32_e32 %0, %1, %2":"=v"(r):"v"(a),"v"(b));return r;}
typedef float f32x2_t __attribute__((ext_vector_type(2))); typedef __bf16 bf16x2_t __attribute__((ext_vector_type(2)));
__device__ __forceinline__ unsigned cvtpk_s(float lo,float hi){f32x2_t v={lo,hi};bf16x2_t b=__builtin_convertvector(v,bf16x2_t);return __builtin_bit_cast(unsigned,b);}
#define WAIT_BAR(N) asm volatile("s_waitcnt vmcnt(" #N ") lgkmcnt(0)\n\ts_barrier":::"memory")

__device__ __forceinline__ void qkt(f32x16&p0,f32x16&p1,const char*Kslot,const bf16x8*qr,const f32x16&negm,int r32,int hi){
  const char*kb=Kslot+hi*1024+r32*16;
  #pragma unroll
  for(int d0=0;d0<4;++d0){
    const bf16x8 b0=*reinterpret_cast<const bf16x8*>(kb+d0*2048);
    const bf16x8 b1=*reinterpret_cast<const bf16x8*>(kb+d0*2048+512);
    if(d0==0){p0=__builtin_amdgcn_mfma_f32_32x32x16_bf16(b0,qr[0],negm,0,0,0);p1=__builtin_amdgcn_mfma_f32_32x32x16_bf16(b1,qr[0],negm,0,0,0);}
    else{p0=__builtin_amdgcn_mfma_f32_32x32x16_bf16(b0,qr[d0],p0,0,0,0);p1=__builtin_amdgcn_mfma_f32_32x32x16_bf16(b1,qr[d0],p1,0,0,0);}}
}
typedef __attribute__((address_space(3))) const char* lds_cptr;
typedef short v4i16_t __attribute__((ext_vector_type(4)));
__device__ __forceinline__ void kload8(bf16x8*kf,lds_cptr kp){
  kf[0]=*(const __attribute__((address_space(3))) bf16x8*)(kp);      kf[1]=*(const __attribute__((address_space(3))) bf16x8*)(kp+512);
  kf[2]=*(const __attribute__((address_space(3))) bf16x8*)(kp+2048); kf[3]=*(const __attribute__((address_space(3))) bf16x8*)(kp+2560);
  kf[4]=*(const __attribute__((address_space(3))) bf16x8*)(kp+4096); kf[5]=*(const __attribute__((address_space(3))) bf16x8*)(kp+4608);
  kf[6]=*(const __attribute__((address_space(3))) bf16x8*)(kp+6144); kf[7]=*(const __attribute__((address_space(3))) bf16x8*)(kp+6656);
}
__device__ __forceinline__ void kload2(bf16x8*kf,lds_cptr kp,int j){ kf[2*j]=*(const __attribute__((address_space(3))) bf16x8*)(kp+j*2048); kf[2*j+1]=*(const __attribute__((address_space(3))) bf16x8*)(kp+j*2048+512); }
__device__ __forceinline__ s16x4 vtr(lds_cptr p){ return __builtin_bit_cast(s16x4,__builtin_amdgcn_ds_read_tr16_b64_v4i16((__attribute__((address_space(3))) v4i16_t*)p)); }
__device__ __forceinline__ float rowmax(const f32x16&p0,const f32x16&p1){
  float a=max3f(p0[0],p0[1],p1[0]),b=max3f(p0[2],p0[3],p1[1]);a=max3f(a,p1[2],p1[3]);
  #pragma unroll
  for(int r=4;r<16;r+=4){a=max3f(a,p0[r],p0[r+1]);b=max3f(b,p0[r+2],p0[r+3]);a=max3f(a,p1[r],p1[r+1]);b=max3f(b,p1[r+2],p1[r+3]);}
  const float m=max2f(a,b);
  auto rr=__builtin_amdgcn_permlane32_swap(__float_as_uint(m),__float_as_uint(m),false,false);
  return max2f(__uint_as_float(rr[0]),__uint_as_float(rr[1]));
}
__device__ __forceinline__ void pv(f32x16*o,int vb,bf16x8 pa0,bf16x8 pa1,bf16x8 pa2,bf16x8 pa3){
  #pragma unroll
  for(int d0=0;d0<2;++d0){s16x4 lo[4],hi[4];
    #pragma unroll
    for(int ks=0;ks<4;++ks){
      asm volatile("ds_read_b64_tr_b16 %0,%1 offset:%c2":"=&v"(lo[ks]):"v"(vb),"i"(d0*4096+ks*1024):"memory");
      asm volatile("ds_read_b64_tr_b16 %0,%1 offset:%c2":"=&v"(hi[ks]):"v"(vb),"i"(d0*4096+ks*1024+512):"memory");}
    asm volatile("s_waitcnt lgkmcnt(0)":::"memory");SBAR();
    #define PK(k) (bf16x8){lo[k][0],lo[k][1],lo[k][2],lo[k][3],hi[k][0],hi[k][1],hi[k][2],hi[k][3]}
    o[d0]=__builtin_amdgcn_mfma_f32_32x32x16_bf16(pa0,PK(0),o[d0],0,0,0);
    o[d0]=__builtin_amdgcn_mfma_f32_32x32x16_bf16(pa1,PK(1),o[d0],0,0,0);
    o[d0]=__builtin_amdgcn_mfma_f32_32x32x16_bf16(pa2,PK(2),o[d0],0,0,0);
    o[d0]=__builtin_amdgcn_mfma_f32_32x32x16_bf16(pa3,PK(3),o[d0],0,0,0);
    #undef PK
  }
}

#ifndef ATTN_STORE16
#define ATTN_STORE16(p,v) (*(u32x4*)(p)=(v))
#endif
template<int MODE,int THRL> __device__ __forceinline__ void attn_unit(const bf16*Qw0,int PQ,const bf16*__restrict__ Kh,int PK,const bf16*__restrict__ Vh,int PV,bf16*Ow0,int PO,int NT,int nabase,int nar0,const float*rpbh,char*shm,int&rot,bool pre,bool hasn,long dKn,long dVn){
  #define NXT(x) (((x)==(NSLOT-1)*SLOTB)?0:(x)+SLOTB)
  int tid_=threadIdx.x; asm volatile("":"+v"(tid_));
  const int tid=tid_,lane=tid&63,r32=lane&31,hi=lane>>5; const int wid=__builtin_amdgcn_readfirstlane(tid>>6);
  const bf16*Qw=Qw0+(long)wid*QBLK*PQ;
  const unsigned lds0=(unsigned)(uintptr_t)shm;
  float*wsf=(float*)(shm+LDS_WS)+wid*64;
  const bf16*ksrc=Kh+(long)lane*PK+wid*8;
  const bf16*vsrc=Vh+(long)(16*(wid&3)+(lane>>2))*PV+(wid>>2)*32+(lane&3)*8;
  const unsigned kdst=lds0+LDS_K+wid*1024, vdst=lds0+LDS_V+wid*1024;
  #define KROW(t) ((t)*KVBLK+((MODE==1&&(t)>=4)?nabase*64:0))
  #define DMA_K(t,slot) glds16(ksrc+(long)KROW(t)*PK,(unsigned)__builtin_amdgcn_readfirstlane(kdst+(slot)))
  #define DMA_V(t,slot) do{ glds16(vsrc+(long)KROW(t)*PV,(unsigned)__builtin_amdgcn_readfirstlane(vdst+2*(slot))); if(MODE==2)glds16(vsrc+(long)KROW(t)*PV+64,(unsigned)__builtin_amdgcn_readfirstlane(vdst+2*(slot)+SLOTB)); }while(0)
  const int vb0=(int)(lds0+LDS_V)+((lane>>4)&1)*32+(lane&3)*8+(4*hi+((lane&15)>>2))*64;
  const char*Kbase=shm+LDS_K; bf16x8 kf[8];
  const lds_cptr shm3=(lds_cptr)shm; const lds_cptr kp0=shm3+LDS_K+hi*1024+r32*16; const lds_cptr vp0=shm3+LDS_V+((lane>>4)&1)*32+(lane&3)*8+(4*hi+((lane&15)>>2))*64;
  const lds_cfptr tb=(lds_cfptr)(shm3+LDS_TB);
  u32x4_t mf[4];
  const int nar=nar0+(wid>>1), nac=(wid&1)*32+r32;
  if(!pre){ DMA_K(0,rot);DMA_V(0,rot);DMA_K(1,NXT(rot)); }
  bf16x8 qr[4];
  #pragma unroll
  for(int d0=0;d0<4;++d0)qr[d0]=*reinterpret_cast<const bf16x8*>(&Qw[(long)r32*PQ+d0*16+hi*8]);
  float mhat=0.f,l_reg=0.f;constexpr int ND=(MODE==2)?4:2; f32x16 o[4];o[0]=f32x16{};o[1]=f32x16{};o[2]=f32x16{};o[3]=f32x16{};f32x16 negm=f32x16{};asm volatile("":"+v"(negm));
  #define CMASK(P0,P1,t) do{ if(MODE==1&&(t)>=4)na_apply(P0,P1,mf,na_rowok((t),nabase,nar)); }while(0)
  #define MFLOAD(tn) do{ if(MODE==1&&(tn)>=4&&(tn)<NT){ if(na_rowok((tn),nabase,nar))na_mfload(mf,(const unsigned*)rpbh,(tn),nabase,nar,wid&1,lane); } }while(0)
  bool resc=false;
  #define START(P0,P1) do{ const float rm=rowmax(P0,P1); resc=false; \
    { const float dl=rm; mhat=fadd_s(mhat,dl); \
      _Pragma("unroll") for(int r=0;r<16;++r){P0[r]=fsub_s(P0[r],dl);P1[r]=fsub_s(P1[r],dl);} \
      _Pragma("unroll") for(int r=0;r<16;++r)negm[r]=-mhat; asm volatile("":"+v"(negm)); } \
    _Pragma("unroll") for(int r=0;r<16;++r)P0[r]=__builtin_amdgcn_exp2f(P0[r]); }while(0)
  #define RESC() do{ if(resc){ asm volatile("s_waitcnt lgkmcnt(0)":::"memory"); \
      _Pragma("unroll") for(int d_=0;d_<ND;++d_) _Pragma("unroll") for(int r=0;r<16;++r)o[d_][r]*=wsf[crow(r,hi)]; } }while(0)
  f32x16 pA0,pA1,pB0,pB1;
  int sl_prev=rot,sl_cur=rot,sl_next=NXT(rot);
  bool pfnow=false;
  #define ROT() do{sl_prev=sl_cur;sl_cur=sl_next;sl_next=(sl_next==(NSLOT-1)*SLOTB)?0:sl_next+SLOTB;}while(0)
  if(!pre){ DMA_K(2,NXT(sl_next)); }
  if(pre){WAIT_BAR(0);}else if(MODE==2){WAIT_BAR(4);}else{WAIT_BAR(3);}
  qkt(pA0,pA1,Kbase+sl_cur,qr,negm,r32,hi);asm volatile("s_nop 15\n\ts_nop 7":"+v"(pA0),"+v"(pA1));CMASK(pA0,pA1,0);
  START(pA0,pA1);
  _Pragma("unroll") for(int r=0;r<16;++r)pA1[r]=__builtin_amdgcn_exp2f(pA1[r]);
  WAIT_BAR(0);
  DMA_K(3,sl_cur);DMA_V(1,sl_next);
  ROT();
  kload8(kf,kp0+sl_cur);
  if(MODE==2){WAIT_BAR(3);}else{WAIT_BAR(2);}
  s16x4 vlo[8],vhi[8]; u32x4 pw0,pw1,pw2,pw3;
  #define PKW(P,B) cvtpk_s(P[B],P[B+1])
  #define PAF(k) __builtin_bit_cast(bf16x8,pw##k)
  #define VFR(i) (bf16x8){vlo[i][0],vlo[i][1],vlo[i][2],vlo[i][3],vhi[i][0],vhi[i][1],vhi[i][2],vhi[i][3]}
  #define PIN(x) asm volatile("":"+v"(x))
  #define MX3(a,b,c) __builtin_fmaxf(__builtin_fmaxf((a),(b)),(c))
  #define GAPA(MF,A0,A1,A2,A3,W0,W1,PW) do{ MF; sacc+=A0; sacc+=A1; sacc+=A2; sacc+=A3; PIN(sacc); W0; W1; PIN(PW); SBAR(); }while(0)
  #define EX(v) __builtin_amdgcn_exp2f(v)
  #define GAPB(MF,X,B) do{ MF; X[B]=EX(X[B]); X[B+1]=EX(X[B+1]); X[B+2]=EX(X[B+2]); X[B+3]=EX(X[B+3]); PIN(X); SBAR(); }while(0)
  #define GAPB2(MF,X,B) do{ MF; X[B]=EX(X[B]); X[B+1]=EX(X[B+1]); PIN(X); SBAR(); }while(0)
  #define GAPB3(MF,X,A,Y,B,Z,C) do{ MF; X[A]=EX(X[A]); Y[B]=EX(Y[B]); Z[C]=EX(Z[C]); PIN(X); PIN(Z); SBAR(); }while(0)
  #define VRD(i) do{ vlo[i]=vtr(vp_+(((i)>>2)*4096+((i)&3)*1024)); vhi[i]=vtr(vp_+(((i)>>2)*4096+((i)&3)*1024+512)); }while(0)
  #define VRD2(i) do{ if(MODE==2){ vlo[i]=vtr(vp_+(SLOTB+((i)>>2)*4096+((i)&3)*1024)); vhi[i]=vtr(vp_+(SLOTB+((i)>>2)*4096+((i)&3)*1024+512)); SBAR(); } }while(0)
  #define KRD(G,j) do{ if(G){ kload2(kf,kp0+sl_next,j); SBAR(); } }while(0)
  #define STEP(C0,C1,P0,P1,t,GK,GV,GL) do{ SBAR(); \
    const lds_cptr vp_=vp0+2*sl_prev; \
    VRD(0); SBAR(); float sacc=(P0[0]+P0[1]); \
    GAPA(C0=__builtin_amdgcn_mfma_f32_32x32x16_bf16(kf[0],qr[0],negm,0,0,0), P0[2],P0[3],P0[4],P0[5],     pw0[0]=PKW(P0,0), pw0[1]=PKW(P0,2), pw0); \
    VRD(4); SBAR(); GAPA(C1=__builtin_amdgcn_mfma_f32_32x32x16_bf16(kf[1],qr[0],negm,0,0,0), P0[6],P0[7],P0[8],P0[9],     pw0[2]=PKW(P0,4), pw0[3]=PKW(P0,6), pw0); \
    VRD(1); SBAR(); GAPA(C0=__builtin_amdgcn_mfma_f32_32x32x16_bf16(kf[2],qr[1],C0,0,0,0),   P0[10],P0[11],P0[12],P0[13], pw1[0]=PKW(P0,8), pw1[1]=PKW(P0,10), pw1); \
    VRD(5); SBAR(); GAPA(C1=__builtin_amdgcn_mfma_f32_32x32x16_bf16(kf[3],qr[1],C1,0,0,0),   P0[14],P0[15],P1[0],P1[1],   pw1[2]=PKW(P0,12),pw1[3]=PKW(P0,14), pw1); \
    VRD(2); SBAR(); GAPA(C0=__builtin_amdgcn_mfma_f32_32x32x16_bf16(kf[4],qr[2],C0,0,0,0),   P1[2],P1[3],P1[4],P1[5],     pw2[0]=PKW(P1,0), pw2[1]=PKW(P1,2), pw2); \
    VRD(6); SBAR(); GAPA(C1=__builtin_amdgcn_mfma_f32_32x32x16_bf16(kf[5],qr[2],C1,0,0,0),   P1[6],P1[7],P1[8],P1[9],     pw2[2]=PKW(P1,4), pw2[3]=PKW(P1,6), pw2); \
    VRD(3); SBAR(); GAPA(C0=__builtin_amdgcn_mfma_f32_32x32x16_bf16(kf[6],qr[3],C0,0,0,0),   P1[10],P1[11],P1[12],P1[13], pw3[0]=PKW(P1,8), pw3[1]=PKW(P1,10), pw3); \
    VRD(7); SBAR(); GAPA(C1=__builtin_amdgcn_mfma_f32_32x32x16_bf16(kf[7],qr[3],C1,0,0,0),   P1[14],P1[15],0.f,0.f,       pw3[2]=PKW(P1,12),pw3[3]=PKW(P1,14), pw3); \
    l_reg+=sacc; \
    CMASK(C0,C1,t); MFLOAD((t)+1); \
    if(GK){DMA_K((t)+3,sl_cur);} if(GV){DMA_V((t)+1,sl_next);} \
    if(pfnow){   \
      const bf16*ksn=ksrc+dKn; const bf16*vsn=vsrc+dVn; \
      glds16(ksn,(unsigned)__builtin_amdgcn_readfirstlane(kdst+sl_next)); \
      glds16(vsn,(unsigned)__builtin_amdgcn_readfirstlane(vdst+2*sl_next)); if(MODE==2)glds16(vsn+64,(unsigned)__builtin_amdgcn_readfirstlane(vdst+2*sl_next+SLOTB)); \
      glds16(ksn+(long)KVBLK*PK,(unsigned)__builtin_amdgcn_readfirstlane(kdst+sl_prev)); \
      glds16(ksn+(long)2*KVBLK*PK,(unsigned)__builtin_amdgcn_readfirstlane(kdst+sl_cur)); } \
    if(MODE==2){   \
      o[0]=__builtin_amdgcn_mfma_f32_32x32x16_bf16(PAF(0),VFR(0),o[0],0,0,0); VRD2(0); \
      o[1]=__builtin_amdgcn_mfma_f32_32x32x16_bf16(PAF(0),VFR(4),o[1],0,0,0); VRD2(4); \
      o[0]=__builtin_amdgcn_mfma_f32_32x32x16_bf16(PAF(1),VFR(1),o[0],0,0,0); VRD2(1); } \
    { float a=MX3(C0[0],C0[1],C1[0]),b=MX3(C0[2],C0[3],C1[1]); a=MX3(a,C1[2],C1[3]); \
      _Pragma("unroll") for(int r=4;r<16;r+=4){a=MX3(a,C0[r],C0[r+1]);b=MX3(b,C0[r+2],C0[r+3]);a=MX3(a,C1[r],C1[r+1]);b=MX3(b,C1[r+2],C1[r+3]);} \
      float rm=__builtin_fmaxf(a,b); { auto rr=__builtin_amdgcn_permlane32_swap(__float_as_uint(rm),__float_as_uint(rm),false,false); rm=__builtin_fmaxf(__uint_as_float(rr[0]),__uint_as_float(rr[1])); } \
      resc=false; \
      if(__builtin_expect(__any(rm>(float)THRL),0)){ const float dl=__builtin_fmaxf(rm,0.f); mhat+=dl; \
        _Pragma("unroll") for(int r=0;r<16;++r){C0[r]-=dl;C1[r]-=dl;} \
        _Pragma("unroll") for(int r=0;r<16;++r)negm[r]=-mhat; asm volatile("":"+v"(negm)); \
        const float f=__builtin_amdgcn_exp2f(-dl); l_reg*=f; if(hi==0)wsf[r32]=f; resc=true; } } \
    SBAR(); \
    if(MODE!=2){ \
    GAPB(o[0]=__builtin_amdgcn_mfma_f32_32x32x16_bf16(PAF(0),VFR(0),o[0],0,0,0), C0,0); \
    GAPB(o[1]=__builtin_amdgcn_mfma_f32_32x32x16_bf16(PAF(0),VFR(4),o[1],0,0,0), C0,4); \
    KRD(GL,0); GAPB(o[0]=__builtin_amdgcn_mfma_f32_32x32x16_bf16(PAF(1),VFR(1),o[0],0,0,0), C0,8); \
    KRD(GL,1); GAPB(o[1]=__builtin_amdgcn_mfma_f32_32x32x16_bf16(PAF(1),VFR(5),o[1],0,0,0), C0,12); \
    KRD(GL,2); GAPB(o[0]=__builtin_amdgcn_mfma_f32_32x32x16_bf16(PAF(2),VFR(2),o[0],0,0,0), C1,0); \
    KRD(GL,3); GAPB(o[1]=__builtin_amdgcn_mfma_f32_32x32x16_bf16(PAF(2),VFR(6),o[1],0,0,0), C1,4); \
    GAPB(o[0]=__builtin_amdgcn_mfma_f32_32x32x16_bf16(PAF(3),VFR(3),o[0],0,0,0), C1,8); \
    GAPB(o[1]=__builtin_amdgcn_mfma_f32_32x32x16_bf16(PAF(3),VFR(7),o[1],0,0,0), C1,12); \
    } else {   \
    KRD(GL,0); GAPB3(o[1]=__builtin_amdgcn_mfma_f32_32x32x16_bf16(PAF(1),VFR(5),o[1],0,0,0), C0,0,C0,1,C0,2); VRD2(5); \
    KRD(GL,1); GAPB3(o[0]=__builtin_amdgcn_mfma_f32_32x32x16_bf16(PAF(2),VFR(2),o[0],0,0,0), C0,3,C0,4,C0,5); VRD2(2); \
    KRD(GL,2); GAPB3(o[1]=__builtin_amdgcn_mfma_f32_32x32x16_bf16(PAF(2),VFR(6),o[1],0,0,0), C0,6,C0,7,C0,8); VRD2(6); \
    KRD(GL,3); GAPB3(o[0]=__builtin_amdgcn_mfma_f32_32x32x16_bf16(PAF(3),VFR(3),o[0],0,0,0), C0,9,C0,10,C0,11); VRD2(3); \
    GAPB3(o[1]=__builtin_amdgcn_mfma_f32_32x32x16_bf16(PAF(3),VFR(7),o[1],0,0,0), C0,12,C0,13,C0,14); VRD2(7); \
    GAPB3(o[2]=__builtin_amdgcn_mfma_f32_32x32x16_bf16(PAF(0),VFR(0),o[2],0,0,0), C0,15,C1,0,C1,1); \
    GAPB2(o[3]=__builtin_amdgcn_mfma_f32_32x32x16_bf16(PAF(0),VFR(4),o[3],0,0,0), C1,2); \
    GAPB2(o[2]=__builtin_amdgcn_mfma_f32_32x32x16_bf16(PAF(1),VFR(1),o[2],0,0,0), C1,4); \
    GAPB2(o[3]=__builtin_amdgcn_mfma_f32_32x32x16_bf16(PAF(1),VFR(5),o[3],0,0,0), C1,6); \
    GAPB2(o[2]=__builtin_amdgcn_mfma_f32_32x32x16_bf16(PAF(2),VFR(2),o[2],0,0,0), C1,8); \
    GAPB2(o[3]=__builtin_amdgcn_mfma_f32_32x32x16_bf16(PAF(2),VFR(6),o[3],0,0,0), C1,10); \
    GAPB2(o[2]=__builtin_amdgcn_mfma_f32_32x32x16_bf16(PAF(3),VFR(3),o[2],0,0,0), C1,12); \
    GAPB2(o[3]=__builtin_amdgcn_mfma_f32_32x32x16_bf16(PAF(3),VFR(7),o[3],0,0,0), C1,14); \
    } \
    }while(0)
  int t=1;
  for(;t+5<NT;t+=2){
    STEP(pB0,pB1,pA0,pA1,t,true,true,true);     if(MODE==2){WAIT_BAR(3);}else{WAIT_BAR(2);} RESC(); ROT();
    STEP(pA0,pA1,pB0,pB1,t+1,true,true,true);   if(MODE==2){WAIT_BAR(3);}else{WAIT_BAR(2);} RESC(); ROT();
  }
  #define CMASK_DUP(P0,P1,t) do{ if(MODE==1&&(t)>=4)namask(P0,P1,(t),nabase,nar,nac,hi,tb); }while(0)
  #define ENDW(tt) do{ if((tt)+3<NT){ if(MODE==2){WAIT_BAR(3);}else{WAIT_BAR(2);} } else if((tt)+2<NT){ if(MODE==2){WAIT_BAR(2);}else{WAIT_BAR(1);} } else {WAIT_BAR(0);} }while(0)
  for(;t+1<NT;t+=2){
    STEP(pB0,pB1,pA0,pA1,t,(t+3<NT),(t+1<NT),(t+1<NT));       ENDW(t);   RESC(); ROT();
    STEP(pA0,pA1,pB0,pB1,t+1,(t+4<NT),(t+2<NT),(t+2<NT));     ENDW(t+1); RESC(); ROT();
  }
  pfnow=hasn; STEP(pB0,pB1,pA0,pA1,NT-1,false,false,false); RESC(); pfnow=false;
  { float sacc=pB0[0]+pB0[1]; _Pragma("unroll") for(int r=2;r<16;++r)sacc+=pB0[r]; _Pragma("unroll") for(int r=0;r<16;++r)sacc+=pB1[r]; l_reg+=sacc;
    pw0=(u32x4){PKW(pB0,0),PKW(pB0,2),PKW(pB0,4),PKW(pB0,6)};pw1=(u32x4){PKW(pB0,8),PKW(pB0,10),PKW(pB0,12),PKW(pB0,14)};pw2=(u32x4){PKW(pB1,0),PKW(pB1,2),PKW(pB1,4),PKW(pB1,6)};pw3=(u32x4){PKW(pB1,8),PKW(pB1,10),PKW(pB1,12),PKW(pB1,14)};
    SBAR(); pv(o,vb0+2*sl_cur,PAF(0),PAF(1),PAF(2),PAF(3)); if(MODE==2){ SBAR(); pv(o+2,vb0+2*sl_cur+SLOTB,PAF(0),PAF(1),PAF(2),PAF(3)); } }
  #undef PKW
  #undef PAF
  #undef VFR
  #undef PIN
  #undef MX3
  #undef GAPA
  #undef GAPB
  #undef GAPB2
  #undef GAPB3
  #undef EX
  #undef VRD
  #undef VRD2
  #undef KRD
  #undef STEP
  #undef ENDW
  {auto rr=__builtin_amdgcn_permlane32_swap(__float_as_uint(l_reg),__float_as_uint(l_reg),false,false);l_reg=__uint_as_float(rr[0])+__uint_as_float(rr[1]);}
  if(hi==0)wsf[32+r32]=l_reg;asm volatile("s_waitcnt lgkmcnt(0)":::"memory");
  float rli[16];
  #pragma unroll
  for(int r=0;r<16;++r)rli[r]=__builtin_amdgcn_rcpf(wsf[32+crow(r,hi)]);
  bf16*Ow=Ow0+(long)wid*QBLK*PO;
  { bf16*stg=(bf16*)(shm+LDS_OST)+wid*2048;
    #pragma unroll
    for(int hf=0;hf<ND/2;++hf){
    #pragma unroll
    for(int r=0;r<16;++r){const int orow=crow(r,hi);
      #pragma unroll
      for(int d0=0;d0<2;++d0)stg[orow*64+d0*32+r32]=__float2bfloat16(o[2*hf+d0][r]*rli[r]);}
    asm volatile("s_waitcnt lgkmcnt(0)":::"memory");
    #pragma unroll
    for(int i=0;i<4;++i){const int row=i*8+(lane>>3),ch=lane&7; const u32x4 v=*(const u32x4*)(stg+row*64+ch*8); ATTN_STORE16(Ow+(long)row*PO+hf*64+ch*8,v);}
    asm volatile("s_waitcnt lgkmcnt(0)":::"memory"); } }
  rot=sl_next;
  asm volatile("s_waitcnt lgkmcnt(0)\n\ts_barrier":::"memory");
  #undef DMA_K
  #undef DMA_V
  #undef KROW
  #undef NXT
  #undef CMASK_DUP
  #undef CMASK
  #undef MFLOAD
  #undef START
  #undef RESC
  #undef ROT
}
constexpr int ATTN_LDS_BYTES=LDS_BYTES;
#undef SBAR
#undef WAIT_BAR
}
constexpr int DMODEL = 1024, NBATCH = 4, SEQ = 8192, CTXL = 256, TPB = SEQ + CTXL  , MROWS = NBATCH * TPB  , DFF = 2816;
constexpr int PAR_IN = 2304, DIFF_IN = 3072, NMOD6 = 6 * DMODEL;
constexpr float EPS = 1e-6f;
constexpr float LAMBDA_INIT = 0.35550906759096925f;
constexpr int NWAVES = 8, NTHREADS = NWAVES * 64;
constexpr size_t WS_W_IN0 = 0;
constexpr size_t WS_W_OUT0 = WS_W_IN0 + (size_t)PAR_IN * DMODEL * 2;
constexpr size_t WS_W_GU0 = WS_W_OUT0 + (size_t)DMODEL * DMODEL * 2;
constexpr size_t WS_W_DN0 = WS_W_GU0 + (size_t)2 * DFF * DMODEL * 2;
constexpr size_t WS_W_IN1 = WS_W_DN0 + (size_t)DMODEL * DFF * 2;
constexpr size_t WS_W_OUT1 = WS_W_IN1 + (size_t)DIFF_IN * DMODEL * 2;
constexpr size_t WS_W_GU1 = WS_W_OUT1 + (size_t)DMODEL * DMODEL * 2;
constexpr size_t WS_W_DN1 = WS_W_GU1 + (size_t)2 * DFF * DMODEL * 2;
constexpr size_t WS_MOD = WS_W_DN1 + (size_t)DMODEL * DFF * 2;
constexpr size_t WS_ROPE = WS_MOD + (size_t)2 * 5 * NMOD6 * 4;
constexpr size_t WS_X = WS_ROPE + (size_t)128 * 16 * 2 * 4;
constexpr size_t WS_XN = WS_X + (size_t)MROWS * DMODEL * 4;
constexpr size_t WS_QKV = WS_XN + (size_t)MROWS * DMODEL * 2;
constexpr size_t WS_END = WS_QKV + (size_t)MROWS * DIFF_IN * 2;
constexpr size_t WS_PART = WS_END + 65536;
static_assert(WS_PART + (size_t)11 * 1024 * 1024 * 4 <= (size_t)512 * 1024 * 1024, "d_ws map");
constexpr size_t WS_MF = WS_PART + (size_t)11 * 1024 * 1024 * 4;
static_assert(WS_MF + (size_t)8 * 15 * 2 * 64 * 32 * 4 <= (size_t)512 * 1024 * 1024, "d_ws map");
constexpr size_t WS_CTL = WS_END;
static_assert(WS_CTL + 65536 <= (size_t)512 * 1024 * 1024 && WS_X % 256 == 0 && WS_XN % 256 == 0 && WS_QKV % 256 == 0 && WS_MOD % 256 == 0, "d_ws map");
constexpr int LDS_TOTAL = 147456;
static_assert(attn_body::ATTN_LDS_BYTES <= pg8::STAGE_BYTES && pg8::STAGE_BYTES <= LDS_TOTAL, "LDS map");

#define LAS __attribute__((address_space(3)))
typedef unsigned short bf16;
typedef unsigned v4u __attribute__((ext_vector_type(4)));
typedef unsigned v2u __attribute__((ext_vector_type(2)));
typedef float f32x4 __attribute__((ext_vector_type(4)));
__device__ __forceinline__ unsigned f2bf(float f) { unsigned u = __builtin_bit_cast(unsigned, f); return (u + 0x7fffu + ((u >> 16) & 1u)) >> 16; }
__device__ __forceinline__ unsigned pk2(float lo, float hi) { return f2bf(lo) | (f2bf(hi) << 16); }
__device__ __forceinline__ float bflo(unsigned w) { return __builtin_bit_cast(float, w << 16); }
__device__ __forceinline__ float bfhi(unsigned w) { return __builtin_bit_cast(float, w & 0xffff0000u); }
__device__ __forceinline__ float wave_sum(float v) {
#pragma unroll
    for (int o = 1; o < 64; o <<= 1) v += __shfl_xor(v, o);
    return v;
}
struct Args {
    const float *x, *c, *ctx, *c_ctx, *ada_w, *ada_b, *w_gate, *w_up, *w_down, *par_w_in, *par_w_out, *na_rpb, *q_gain, *k_gain, *diff_w_in, *diff_w_out, *lq1, *lk1, *lq2, *lk2, *subln, *fgain;
    float* out; unsigned char* ws;
};
__device__ __forceinline__ void transpose_item(const float* W, int K, int N, bf16* WT, LAS float* scr, int k0, int n0, int wrow0, int lane) {
    float tv[32];
#pragma unroll
    for (int i = 0; i < 32; ++i) tv[i] = W[(size_t)(k0 + 2 * i + (lane >> 5)) * N + n0 + (lane & 31)];
#pragma unroll
    for (int i = 0; i < 32; ++i) scr[(2 * i + (lane >> 5)) * 33 + (lane & 31)] = tv[i];
    asm volatile("s_waitcnt lgkmcnt(0)" ::: "memory");
    const int c = lane & 7;
#pragma unroll
    for (int j = 0; j < 4; ++j) { const int n = (lane >> 3) + 8 * j; const LAS float* s = scr + (8 * c) * 33 + n;
        v4u o; o.x = pk2(s[0 * 33], s[1 * 33]); o.y = pk2(s[2 * 33], s[3 * 33]); o.z = pk2(s[4 * 33], s[5 * 33]); o.w = pk2(s[6 * 33], s[7 * 33]);
        *(v4u*)(WT + (size_t)(wrow0 + n) * K + k0 + 8 * c) = o; }
    asm volatile("s_waitcnt lgkmcnt(0)" ::: "memory");
}
__device__ __forceinline__ bool transpose_mat(int& r, const float* W, int K, int N, bf16* WT, int gu, LAS float* scr, int lane) {
    const int nblk = N / 32, cnt = (K / 64) * nblk;
    if (r >= cnt) { r -= cnt; return false; }
    const int kb = r / nblk, nb = r % nblk, n0 = 32 * nb;
    const int wrow0 = gu ? (256 * (n0 / 128) + 128 * (gu - 1) + (n0 % 128)) : n0;
    transpose_item(W, K, N, WT, scr, 64 * kb, n0, wrow0, lane); return true;
}
__device__ __forceinline__ const float* row_src(int row, const float* lat, long lat_bs, const float* cx, long ctx_bs, int& s) {
    const int b = row / TPB, t = row - b * TPB;
    if (t < CTXL) { s = 4; return cx + (size_t)b * ctx_bs + (size_t)t * DMODEL; }
    s = b; return lat + (size_t)b * lat_bs + (size_t)(t - CTXL) * DMODEL;
}
__device__ __forceinline__ void norm_mod_phase(const float* lat, long lat_bs, const float* cx, long ctx_bs, const float* modl, int shoff, int scoff, bf16* XN, int skip_ctx, int gw, int NGW, float* xcopy, const float* part, int nkc, const float* pgate) {
    int t_ = threadIdx.x; asm volatile("" : "+v"(t_)); const int lane = t_ & 63;
    f32x4 vn[4]; int sn = 0;
    { if (gw < MROWS) { const float* src = row_src(gw, lat, lat_bs, cx, ctx_bs, sn); const f32x4* xr = (const f32x4*)src + lane;
#pragma unroll
        for (int j = 0; j < 4; ++j) vn[j] = xr[64 * j]; } }
    for (int row = gw; row < MROWS; row += NGW) {
        const int s = sn; f32x4 v[4]; float ss = 0.f;
#pragma unroll
        for (int j = 0; j < 4; ++j) v[j] = vn[j];
        if (row + NGW < MROWS) { const float* srcn = row_src(row + NGW, lat, lat_bs, cx, ctx_bs, sn); const f32x4* xr = (const f32x4*)srcn + lane;
#pragma unroll
            for (int j = 0; j < 4; ++j) vn[j] = xr[64 * j]; }
        if (skip_ctx && s == 4) continue;
#pragma unroll
        for (int j = 0; j < 4; ++j) ss += (v[j].x * v[j].x + v[j].y * v[j].y) + (v[j].z * v[j].z + v[j].w * v[j].w);
        if (xcopy && s == 4) {
            const int b_ = row / TPB, cr = b_ * CTXL + (row - b_ * TPB); const f32x4* gp = (const f32x4*)(pgate + 4 * NMOD6) + lane;
            f32x4 sm[4];
#pragma unroll
            for (int j = 0; j < 4; ++j) sm[j] = (f32x4){0.f, 0.f, 0.f, 0.f};
            for (int kc = 0; kc < nkc; ++kc) { const f32x4* pp = (const f32x4*)(part + ((size_t)kc * 1024 + cr) * DMODEL) + lane;
#pragma unroll
                for (int j = 0; j < 4; ++j) sm[j] += pp[64 * j]; }
            f32x4* xc = (f32x4*)(xcopy + (size_t)row * DMODEL) + lane; ss = 0.f;
#pragma unroll
            for (int j = 0; j < 4; ++j) { v[j] += gp[64 * j] * sm[j]; xc[64 * j] = v[j]; ss += (v[j].x * v[j].x + v[j].y * v[j].y) + (v[j].z * v[j].z + v[j].w * v[j].w); } }
        const float rstd = 1.0f / sqrtf(wave_sum(ss) * (1.0f / DMODEL) + EPS);
        const f32x4* sh = (const f32x4*)(modl + s * NMOD6 + shoff) + lane; const f32x4* sc = (const f32x4*)(modl + s * NMOD6 + scoff) + lane;
        v2u* o8 = (v2u*)(XN + (size_t)row * DMODEL) + lane;
#pragma unroll
        for (int j = 0; j < 4; ++j) { const f32x4 a = sh[64 * j], m = sc[64 * j]; const f32x4 y = v[j] * rstd * (m + 1.0f) + a; v2u w; w.x = pk2(y.x, y.y); w.y = pk2(y.z, y.w); o8[64 * j] = w; }
    }
}
typedef __attribute__((address_space(1))) unsigned gu32;
#define XB_TMO      128
#define XB_XCNT(j)  (256  + 64 * (j))
#define XB_XSUB(j)  (1280 + 64 * (j))
#define XB_XGEN(j)  (2304 + 64 * (j))
#define XB_TOP      3328
#define XB_TOPGEN   3392
#define XCD_BAR_WORDS 3456
#define XB_SPIN_CAP (1u << 18)

__device__ __forceinline__ unsigned xb_ld(unsigned* p)              { return __hip_atomic_load(p, __ATOMIC_RELAXED, __HIP_MEMORY_SCOPE_AGENT); }
__device__ __forceinline__ unsigned xb_add(unsigned* p, unsigned v) { return __hip_atomic_fetch_add(p, v, __ATOMIC_RELAXED, __HIP_MEMORY_SCOPE_AGENT); }
__device__ __forceinline__ unsigned xb_xcc_id() { return (unsigned)__builtin_amdgcn_s_getreg((3 << 11) | 20) & 0xFu; }
#define XB_SPIN(cond, bar) do { unsigned _sp = 0; while (cond) { __builtin_amdgcn_s_sleep(1); \
    if ((++_sp & 255u) == 0u) { if (xb_ld(&(bar)[XB_TMO])) break; if (_sp > XB_SPIN_CAP) { atomicAdd(&(bar)[XB_TMO], 1u); break; } } } } while (0)

struct XcdBarrier {
    unsigned* bar; unsigned x;
    volatile LAS unsigned* st;
};

__device__ __forceinline__ XcdBarrier xcd_barrier_post(unsigned* bar, volatile LAS unsigned* st) {
    XcdBarrier b; b.bar = bar; b.x = xb_xcc_id(); b.st = st;
    if (threadIdx.x == 0) (void)xb_add(&bar[XB_XCNT(b.x)], 1u);
    return b;
}
__device__ __forceinline__ void xcd_barrier_complete(unsigned* bar, unsigned x, unsigned& nloc, unsigned& nx) {
    const unsigned G = gridDim.x * gridDim.y * gridDim.z;
    unsigned sum, cnt, mine, sp = 0u;
    for (;;) {
        sum = 0u; cnt = 0u; mine = 0u;
#pragma unroll
        for (unsigned j = 0; j < 16; ++j) { const unsigned c = xb_ld(&bar[XB_XCNT(j)]); sum += c; cnt += (c > 0u) ? 1u : 0u; mine = (j == x) ? c : mine; }
        if (sum == G) break;
        __builtin_amdgcn_s_sleep(1);
        if ((++sp & 255u) == 0u) { if (xb_ld(&bar[XB_TMO])) break; if (sp > XB_SPIN_CAP) { atomicAdd(&bar[XB_TMO], 1u); break; } }
    }
    nloc = mine > 0u ? mine : 1u; nx = cnt > 0u ? cnt : 1u;
}

__device__ __forceinline__ void xcd_barrier(const XcdBarrier& b) {
    asm volatile("s_waitcnt vmcnt(0)" ::: "memory");
    __syncthreads();
    if (threadIdx.x == 0) {
        unsigned* bar = b.bar;
        __builtin_amdgcn_s_waitcnt(0);
        unsigned nloc = b.st[0], nx = b.st[1];
        if (nloc == 0u) { xcd_barrier_complete(bar, b.x, nloc, nx); b.st[0] = nloc; b.st[1] = nx; }
        const unsigned old = xb_add(&bar[XB_XSUB(b.x)], 1u);
        const unsigned gen = old / nloc;
        if (old + 1u == (gen + 1u) * nloc) {
            __builtin_amdgcn_fence(__ATOMIC_RELEASE, "agent");
            asm volatile("s_waitcnt vmcnt(0)" ::: "memory");
            const unsigned og = xb_add(&bar[XB_TOP], 1u);
            const unsigned tg = og / nx;
            if (og + 1u == (tg + 1u) * nx) xb_add(&bar[XB_TOPGEN], 1u);
            else XB_SPIN(xb_ld(&bar[XB_TOPGEN]) == tg, bar);
            __builtin_amdgcn_fence(__ATOMIC_ACQUIRE, "agent");
            xb_add(&bar[XB_XGEN(b.x)], 1u);
            asm volatile("s_waitcnt vmcnt(0)" ::: "memory");
        } else {
            XB_SPIN(xb_ld(&bar[XB_XGEN(b.x)]) == gen, bar);
            __builtin_amdgcn_fence(__ATOMIC_ACQUIRE, "agent");
            asm volatile("s_waitcnt vmcnt(0)" ::: "memory");
        }
    }
    __syncthreads();
}

#define FRESH_LANE() ({ int t_ = threadIdx.x; asm volatile("" : "+v"(t_)); t_ & 63; })
struct AttnDesc { const attn_body::bf16 *Q, *K, *V; attn_body::bf16* O; int PQ, PK, PV, PO, NT; };

#define W_IN(l) ((bf16*)(ws + ((l) ? WS_W_IN1 : WS_W_IN0)))
#define W_OUT(l) ((bf16*)(ws + ((l) ? WS_W_OUT1 : WS_W_OUT0)))
#define W_GU(l) ((bf16*)(ws + ((l) ? WS_W_GU1 : WS_W_GU0)))
#define W_DN(l) ((bf16*)(ws + ((l) ? WS_W_DN1 : WS_W_DN0)))
template <int l> __device__ __forceinline__ void layer_body(const Args& a, unsigned char* lds, const XcdBarrier& bar, int G, int bx, int vcu, int gw, int NGW, int lane_, int tid_k, int wave) {
    unsigned char* ws = a.ws;
    float* MOD = (float*)(ws + WS_MOD); float* ROPE = (float*)(ws + WS_ROPE); float* X = (float*)(ws + WS_X);
    bf16* XN = (bf16*)(ws + WS_XN); bf16* QKV = (bf16*)(ws + WS_QKV); bf16* HB = QKV; bf16* AO = XN; bf16* OP = (bf16*)a.out;
    LAS unsigned char* ldsl = (LAS unsigned char*)lds;
        const float* modl = MOD + (size_t)l * 5 * NMOD6;
        const int last = (l == 1);
        const float* lat = l == 0 ? a.x : X + (size_t)CTXL * DMODEL; const long lat_bs = l == 0 ? (long)SEQ * DMODEL : (long)TPB * DMODEL;
        const float* cxs = l == 0 ? a.ctx : X; const long ctx_bs = l == 0 ? (long)CTXL * DMODEL : (long)TPB * DMODEL;
        norm_mod_phase(lat, lat_bs, cxs, ctx_bs, modl, 0, DMODEL, XN, 0, gw, NGW, l == 1 ? X : nullptr, (const float*)(ws + WS_PART), 11, MOD + 5 * DMODEL);
        xcd_barrier(bar);
        {
            if constexpr (l == 0) {
                pg8::Gemm g{XN, W_IN(0), MROWS, PAR_IN, DMODEL, DMODEL}; pg8::StaticOrder S; S.init(MROWS, PAR_IN, G, bx);
                pg8::EpiBf16<0> E{QKV, PAR_IN, nullptr, 512, 512, attn_body::C2};
                pg8::gemm_phase<pg8::EpiBf16<0>, pg8::StaticOrder, PG8_ALIGN, PG8_SP2>(ldsl, g, S, E);
            } else {
                pg8::Gemm g{XN, W_IN(1), MROWS, DIFF_IN, DMODEL, DMODEL}; pg8::StaticOrder S; S.init(MROWS, DIFF_IN, G, bx);
                pg8::EpiQKVRope E{QKV, DIFF_IN, ROPE, attn_body::C2};
                pg8::gemm_phase<pg8::EpiQKVRope, pg8::StaticOrder, PG8_ALIGN, PG8_SP2>(ldsl, g, S, E);
            }
        }
        xcd_barrier(bar);
        if constexpr (l == 0) {
            const int lane = FRESH_LANE();
            for (int row = gw; row < MROWS; row += NGW) {
                const int b = row / TPB, t = row - b * TPB; const bool islat = t >= CTXL; const int pos = t - CTXL;
                unsigned* rp = (unsigned*)(QKV + (size_t)row * PAR_IN + 1536);
#pragma unroll
                for (int j = 0; j < 5; ++j) { const int p = lane + 64 * j, head = p >> 5, i = p & 31; const unsigned w = rp[p];
                    float x1 = bflo(w), x2 = bfhi(w); float ss = x1 * x1 + x2 * x2;
#pragma unroll
                    for (int o = 1; o < 32; o <<= 1) ss += __shfl_xor(ss, o);
                    const float rstd = 1.0f / sqrtf(ss * (1.0f / 64.0f) + EPS); const float* gn = head < 8 ? a.q_gain : a.k_gain;
                    x1 = x1 * rstd * gn[2 * i]; x2 = x2 * rstd * gn[2 * i + 1];
                    if (islat) { const int pp = (i < 16) ? (pos >> 6) : (pos & 63); const float cs = ROPE[(pp * 16 + (i & 15)) * 2], sn = ROPE[(pp * 16 + (i & 15)) * 2 + 1];
                        const float y1 = x1 * cs - x2 * sn, y2 = x1 * sn + x2 * cs; x1 = y1; x2 = y2; }
                    if (head < 8) { x1 *= attn_body::C2; x2 *= attn_body::C2; }
                    rp[p] = pk2(x1, x2); }
            }
            xcd_barrier(bar);
        }
        {
            typedef attn_body::bf16 abf; abf* qkv = (abf*)QKV;
            if constexpr (l == 0) {
                const int pern = (1024 + G - 1) / G; int rot = 0; bool pre = false;
                for (int i = 0; i < pern; ++i) { const int n = vcu * pern + i; if (n >= 1024) break;
                    const int b = n >> 8, h = (n >> 5) & 7, qb = n & 31; const int r0 = qb * 4; int nb = r0 - 4; nb = nb < 0 ? 0 : (nb > 116 ? 116 : nb);
                    const size_t rb = (size_t)b * TPB, rq = rb + CTXL + (size_t)qb * 256;
                    const int n2 = n + 1; const bool hasn = (i + 1 < pern) && (n2 < 1024); const int b2 = n2 >> 8, h2 = (n2 >> 5) & 7; const size_t rb2 = (size_t)b2 * TPB;
                    attn_body::attn_unit<1, 8>(qkv + rq * PAR_IN + h * 64, PAR_IN, qkv + rb * PAR_IN + 512 + h * 64, PAR_IN, qkv + rb * PAR_IN + 1024 + h * 64, PAR_IN,
                                               (abf*)AO + rq * DMODEL + h * 64, DMODEL, 16, nb, r0, (const float*)(ws + WS_MF) + (size_t)h * (15 * 2 * 64 * 16), (char*)lds,
                                               rot, pre, hasn, (long)((rb2 * PAR_IN + h2 * 64) - (rb * PAR_IN + h * 64)), (long)((rb2 * PAR_IN + h2 * 64) - (rb * PAR_IN + h * 64)));
                    pre = hasn; }
            }
            if constexpr (l == 0) {
                const int nun = 1024 + 64; const int per = (nun + G - 1) / G; int rot = 0; bool pre = false;
#define L0_UNIT_G(i_, g_, ok_) do { ok_ = true; if ((i_) < 4) g_ = vcu * 4 + (i_); else { g_ = 1024 + vcu; if (vcu >= 64) ok_ = false; } if (G != 256) { g_ = (i_) * G + vcu; ok_ = g_ < nun; } if ((i_) >= per) ok_ = false; } while (0)
#define L0_UNIT_DESC(d_, g_) do { if (g_ < 1024) { const int bk = g_ >> 7, b = bk >> 1, kvh = bk & 1, rem = g_ & 127, head = kvh * 4 + (rem >> 5), qb = rem & 31; \
                        const size_t rb = (size_t)b * TPB, rq = rb + CTXL + (size_t)qb * 256; \
                        d_.Q = qkv + rq * PAR_IN + 1536 + head * 64; d_.K = qkv + rb * PAR_IN + 2048 + kvh * 64; d_.V = qkv + rb * PAR_IN + 2176 + kvh * 64; d_.O = (abf*)AO + rq * DMODEL + 512 + head * 64; \
                        d_.PQ = d_.PK = d_.PV = PAR_IN; d_.PO = DMODEL; d_.NT = TPB / 64; } \
                    else { const int u = g_ - 1024, b = u >> 4, hd = u & 15; const size_t rb = (size_t)b * TPB; \
                        if (hd < 8) { d_.Q = qkv + rb * PAR_IN + hd * 64; d_.K = qkv + rb * PAR_IN + 512 + hd * 64; d_.V = qkv + rb * PAR_IN + 1024 + hd * 64; } \
                        else { const int gh = hd - 8; d_.Q = qkv + rb * PAR_IN + 1536 + gh * 64; d_.K = qkv + rb * PAR_IN + 2048 + (gh >> 2) * 64; d_.V = qkv + rb * PAR_IN + 2176 + (gh >> 2) * 64; } \
                        d_.O = (abf*)AO + rb * DMODEL + hd * 64; d_.PQ = d_.PK = d_.PV = PAR_IN; d_.PO = DMODEL; d_.NT = CTXL / 64; } } while (0)
                for (int i = 0; i < per; ++i) {
                    AttnDesc d, d2; bool ok, ok2; int g, g2;
                    L0_UNIT_G(i, g, ok); L0_UNIT_G(i + 1, g2, ok2);
                    if (!ok) { pre = false; continue; }
                    L0_UNIT_DESC(d, g); d2 = d; if (ok2) L0_UNIT_DESC(d2, g2);
                    attn_body::attn_unit<0, 8>(d.Q, d.PQ, d.K, d.PK, d.V, d.PV, d.O, d.PO, d.NT, 0, 0, nullptr, (char*)lds, rot, pre, ok2, (long)(d2.K - d.K), (long)(d2.V - d.V));
                    pre = ok2;
                }
#undef L0_UNIT_G
#undef L0_UNIT_DESC
            } else {
                const int nun = 2048; const int per = (nun + G - 1) / G;
                const float lam = expf(wave_sum(a.lq1[FRESH_LANE()] * a.lk1[FRESH_LANE()])) - expf(wave_sum(a.lq2[FRESH_LANE()] * a.lk2[FRESH_LANE()])) + LAMBDA_INIT;
                int rot = 0; bool pre = false;
                for (int i = 0; i < per; ++i) {
                    int g; bool ok = true; if (G == 256) g = (((vcu >> 5) * 4 + (i >> 1)) << 6) + (i & 1) * 32 + (vcu & 31); else { g = i * G + vcu; ok = g < nun; }
                    int g2; bool ok2 = (i + 1 < per); if (G == 256) g2 = (((vcu >> 5) * 4 + ((i + 1) >> 1)) << 6) + ((i + 1) & 1) * 32 + (vcu & 31); else { g2 = (i + 1) * G + vcu; ok2 = ok2 && g2 < nun; }
                    if (!ok2) g2 = g;
                    const int bh2 = g2 >> 6, b2 = bh2 >> 3, h2 = bh2 & 7, map2 = (g2 & 63) >> 5; const size_t rb2 = (size_t)b2 * TPB;
                    if (!ok) pre = false;
                    if (ok) { const int bh = g >> 6, b = bh >> 3, h = bh & 7, sub = g & 63, map = sub >> 5, qb = sub & 31;
                        const size_t rb = (size_t)b * TPB, rq = rb + CTXL + (size_t)qb * 256;
                        attn_body::attn_unit<2, 8>(qkv + rq * DIFF_IN + h * 128 + map * 64, DIFF_IN, qkv + rb * DIFF_IN + 1024 + h * 128 + map * 64, DIFF_IN, qkv + rb * DIFF_IN + 2048 + h * 128, DIFF_IN,
                                                   (abf*)OP + ((size_t)b * SEQ + (size_t)qb * 256) * 2048 + map * 1024 + h * 128, 2048, TPB / 64, 0, 0, nullptr, (char*)lds,
                                                   rot, pre, ok2, (long)(rb2 * DIFF_IN + h2 * 128 + map2 * 64) - (long)(rb * DIFF_IN + h * 128 + map * 64), (long)(rb2 * DIFF_IN + h2 * 128) - (long)(rb * DIFF_IN + h * 128));
                        pre = ok2;
                        if (G == 256 && map == 1) {
                            asm volatile("s_waitcnt vmcnt(0)" ::: "memory"); __builtin_amdgcn_fence(__ATOMIC_SEQ_CST, "workgroup");
                            const int lane = FRESH_LANE(), rsub = lane >> 3, ch = lane & 7;
                            const f32x4* gp = (const f32x4*)(a.subln + ch * 16); const f32x4 g0 = gp[0], g1 = gp[1], g2 = gp[2], g3 = gp[3];
                            const float gn[16] = {g0.x, g0.y, g0.z, g0.w, g1.x, g1.y, g1.z, g1.w, g2.x, g2.y, g2.z, g2.w, g3.x, g3.y, g3.z, g3.w};
#pragma unroll
                            for (int it = 0; it < 4; ++it) { const int r = wave * 32 + it * 8 + rsub; const size_t lr = (size_t)b * SEQ + (size_t)qb * 256 + r;
                                const v4u* p1 = (const v4u*)(OP + lr * 2048 + h * 128) + ch * 2; const v4u* p2 = (const v4u*)(OP + lr * 2048 + 1024 + h * 128) + ch * 2;
                                const v4u a0 = p1[0], a1 = p1[1], b0 = p2[0], b1 = p2[1];
                                const unsigned wa[8] = {a0.x, a0.y, a0.z, a0.w, a1.x, a1.y, a1.z, a1.w}, wb[8] = {b0.x, b0.y, b0.z, b0.w, b1.x, b1.y, b1.z, b1.w};
                                float o[16]; float ss = 0.f;
#pragma unroll
                                for (int e = 0; e < 8; ++e) { o[2 * e] = bflo(wa[e]) - lam * bflo(wb[e]); o[2 * e + 1] = bfhi(wa[e]) - lam * bfhi(wb[e]); ss += o[2 * e] * o[2 * e] + o[2 * e + 1] * o[2 * e + 1]; }
                                ss += __shfl_xor(ss, 1); ss += __shfl_xor(ss, 2); ss += __shfl_xor(ss, 4);
                                const float rs = (1.0f - LAMBDA_INIT) / sqrtf(ss * (1.0f / 128.0f) + EPS);
                                unsigned w[8];
#pragma unroll
                                for (int e = 0; e < 8; ++e) w[e] = pk2(o[2 * e] * rs * gn[2 * e], o[2 * e + 1] * rs * gn[2 * e + 1]);
                                v4u* op = (v4u*)(AO + (rq + r) * DMODEL + h * 128) + ch * 2; op[0] = (v4u){w[0], w[1], w[2], w[3]}; op[1] = (v4u){w[4], w[5], w[6], w[7]}; }
                        }
                    }
                }
            }
        }
        xcd_barrier(bar);
        if (l == 1 && G != 256) {
            const int lane = FRESH_LANE();
            const float d1 = wave_sum(a.lq1[lane] * a.lk1[lane]), d2 = wave_sum(a.lq2[lane] * a.lk2[lane]);
            const float lam = expf(d1) - expf(d2) + LAMBDA_INIT;
            const f32x4* gp = (const f32x4*)(a.subln + (lane & 7) * 16); const f32x4 g0 = gp[0], g1 = gp[1], g2 = gp[2], g3 = gp[3];
            const float gn[16] = {g0.x, g0.y, g0.z, g0.w, g1.x, g1.y, g1.z, g1.w, g2.x, g2.y, g2.z, g2.w, g3.x, g3.y, g3.z, g3.w};
            for (int lr = gw; lr < NBATCH * SEQ; lr += NGW) {
                const int b = lr / SEQ, pos = lr - b * SEQ; const size_t row = (size_t)b * TPB + CTXL + pos;
                const v4u* p1 = (const v4u*)(OP + (size_t)lr * 2048) + lane * 2; const v4u* p2 = p1 + 128;
                const v4u a0 = p1[0], a1 = p1[1], b0 = p2[0], b1 = p2[1];
                const unsigned wa[8] = {a0.x, a0.y, a0.z, a0.w, a1.x, a1.y, a1.z, a1.w}, wb[8] = {b0.x, b0.y, b0.z, b0.w, b1.x, b1.y, b1.z, b1.w};
                float o[16]; float ss = 0.f;
#pragma unroll
                for (int e = 0; e < 8; ++e) { o[2 * e] = bflo(wa[e]) - lam * bflo(wb[e]); o[2 * e + 1] = bfhi(wa[e]) - lam * bfhi(wb[e]); ss += o[2 * e] * o[2 * e] + o[2 * e + 1] * o[2 * e + 1]; }
                ss += __shfl_xor(ss, 1); ss += __shfl_xor(ss, 2); ss += __shfl_xor(ss, 4);
                const float rs = (1.0f - LAMBDA_INIT) / sqrtf(ss * (1.0f / 128.0f) + EPS);
                unsigned w[8];
#pragma unroll
                for (int e = 0; e < 8; ++e) w[e] = pk2(o[2 * e] * rs * gn[2 * e], o[2 * e + 1] * rs * gn[2 * e + 1]);
                v4u* op = (v4u*)(AO + row * DMODEL) + lane * 2; op[0] = (v4u){w[0], w[1], w[2], w[3]}; op[1] = (v4u){w[4], w[5], w[6], w[7]};
            }
            xcd_barrier(bar);
        }
        {
            pg8::Gemm g{AO, W_OUT(l), MROWS, DMODEL, DMODEL, DMODEL}; pg8::StaticOrder S; S.init(MROWS, DMODEL, G, bx, 1);
            pg8::EpiRes E{lat, lat_bs, cxs, ctx_bs, X, modl + 2 * DMODEL};
            pg8::gemm_phase<pg8::EpiRes, pg8::StaticOrder, PG8_ALIGN, PG8_SP2>(ldsl, g, S, E);
            if constexpr (l == 0) {
                pg8::Gemm gc{AO, W_OUT(0), MROWS, DMODEL, 256, DMODEL}; pg8::CtxSplitOrder Sc; Sc.init(4, G, bx);
                pg8::EpiPartial Ec{(float*)(ws + WS_PART)};
                pg8::gemm_phase<pg8::EpiPartial, pg8::CtxSplitOrder, PG8_ALIGN, PG8_SP2>(ldsl, gc, Sc, Ec);
            }
        }
        xcd_barrier(bar);
        norm_mod_phase(X + (size_t)CTXL * DMODEL, (long)TPB * DMODEL, l == 0 ? a.ctx : X, l == 0 ? (long)CTXL * DMODEL : (long)TPB * DMODEL, modl, 3 * DMODEL, 4 * DMODEL, XN, last, gw, NGW, l == 0 ? X : nullptr, (const float*)(ws + WS_PART), 4, modl + 2 * DMODEL);
        xcd_barrier(bar);
        {
            pg8::Gemm g{XN, W_GU(l), MROWS, 2 * DFF, DMODEL, DMODEL}; pg8::StaticOrder S; S.init(MROWS, 2 * DFF, G, bx, last);
            pg8::EpiSwiGLU E{HB, DFF};
            pg8::gemm_phase<pg8::EpiSwiGLU, pg8::StaticOrder, PG8_ALIGN, PG8_SP2>(ldsl, g, S, E);
        }
        xcd_barrier(bar);
        {
            pg8::Gemm g{HB, W_DN(l), MROWS, DMODEL, DFF, DFF}; pg8::StaticOrder S; S.init(MROWS, DMODEL, G, bx, 1);
            pg8::EpiRes E{X + (size_t)CTXL * DMODEL, (long)TPB * DMODEL, X, (long)TPB * DMODEL, X, modl + 5 * DMODEL};
            pg8::gemm_phase<pg8::EpiRes, pg8::StaticOrder, PG8_ALIGN, PG8_SP2>(ldsl, g, S, E);
            if constexpr (l == 0) {
                pg8::Gemm gc{HB, W_DN(0), MROWS, DMODEL, 256, DFF}; pg8::CtxSplitOrder Sc; Sc.init(11, G, bx);
                pg8::EpiPartial Ec{(float*)(ws + WS_PART)};
                pg8::gemm_phase<pg8::EpiPartial, pg8::CtxSplitOrder, PG8_ALIGN, PG8_SP2>(ldsl, gc, Sc, Ec);
            }
        }
        xcd_barrier(bar);
    }

__global__ void __launch_bounds__(NTHREADS, 2) fwd_megakernel(Args a) {
    __shared__ __attribute__((aligned(16))) unsigned char lds[LDS_TOTAL];
    cg::grid_group grid = cg::this_grid();
    const int tid = threadIdx.x, lane = tid & 63, wave = __builtin_amdgcn_readfirstlane(tid >> 6);
    const int G = gridDim.x, bx = blockIdx.x;
    const int vcu = (G % 8 == 0) ? (bx % 8) * (G / 8) + bx / 8 : bx;
    const int gw = vcu * NWAVES + wave, NGW = G * NWAVES;
    unsigned char* ws = a.ws;
    float* MOD = (float*)(ws + WS_MOD); float* ROPE = (float*)(ws + WS_ROPE); float* X = (float*)(ws + WS_X);
    bf16* XN = (bf16*)(ws + WS_XN); bf16* QKV = (bf16*)(ws + WS_QKV); bf16* HB = QKV; bf16* AO = XN; bf16* OP = (bf16*)a.out;
    LAS unsigned char* ldsl = (LAS unsigned char*)lds;

    volatile LAS unsigned* bst = (volatile LAS unsigned*)(ldsl + 131072 + 512);
    if (tid < 2) bst[tid] = 0u;
    unsigned* barw = (unsigned*)(ws + WS_CTL);
    if (bx == 0) for (int i = tid; i < XCD_BAR_WORDS; i += NTHREADS) barw[i] = 0u;
    {
        for (int it = bx; it < 192; it += G) {
            LAS float* sl = (LAS float*)ldsl;
            LAS float* part = sl + 5 * 1024;
            for (int i = tid; i < 5 * 1024; i += NTHREADS) { const float cv = (i < 4096) ? a.c[i] : a.c_ctx[i - 4096]; sl[i] = cv / (1.0f + __expf(-cv)); }
            __syncthreads();
            const int l = it / 96, n = (it % 96) * 64 + lane; const float* wp = a.ada_w + (size_t)l * DMODEL * NMOD6 + n;
            float acc[5] = {0.f, 0.f, 0.f, 0.f, 0.f};
#pragma unroll 32
            for (int k = wave * 128; k < wave * 128 + 128; ++k) { const float w = wp[(size_t)k * NMOD6];
#pragma unroll
                for (int s = 0; s < 5; ++s) acc[s] += sl[s * 1024 + k] * w; }
#pragma unroll
            for (int s = 0; s < 5; ++s) part[(wave * 5 + s) * 64 + lane] = acc[s];
            __syncthreads();
            if (tid < 320) { const int s = tid / 64, ln = tid % 64; float t = a.ada_b[l * NMOD6 + (it % 96) * 64 + ln];
#pragma unroll
                for (int w = 0; w < 8; ++w) t += part[(w * 5 + s) * 64 + ln];
                MOD[(size_t)(l * 5 + s) * NMOD6 + (it % 96) * 64 + ln] = t; }
            __syncthreads();
        }
        {
            unsigned* MF = (unsigned*)(ws + WS_MF);
            for (int idx = bx * NTHREADS + tid; idx < 8 * 15 * 2 * 64 * 16; idx += G * NTHREADS) {
                const int w = idx & 15, ln = (idx >> 4) & 63, chalf = (idx >> 10) & 1, rest = idx >> 11, dr = rest % 15, h = rest / 15;
                const int hi = ln >> 5, c = chalf * 32 + (ln & 31); int cs = c - 8; cs = cs < 0 ? 0 : (cs > 48 ? 48 : cs);
                unsigned pr[2];
#pragma unroll
                for (int q = 0; q < 2; ++q) { const int e = 2 * w + q, ee = e & 15, j = (ee & 3) + 8 * (ee >> 2) + 4 * hi + (e >= 16 ? 32 : 0);
                    pr[q] = (j >= cs && j < cs + 16) ? f2bf(a.na_rpb[h * 465 + dr * 31 + (j - c + 15)] * 1.4426950408889634f) : 0xff80u; }
                MF[idx] = pr[0] | (pr[1] << 16);
            }
        }
        if (bx == G - 1) {
            for (int i = tid; i < 128 * 16; i += NTHREADS) { const int pos = i / 16, f = i % 16; const float inv = powf(10000.0f, -(float)f / 16.0f); const float ang = (float)pos * inv;
                ROPE[2 * i] = cosf(ang); ROPE[2 * i + 1] = sinf(ang); }
        }
        __syncthreads();
        LAS float* scr = (LAS float*)(ldsl + wave * 16384);
        constexpr int NITEMS = 16 * (PAR_IN / 32) + 16 * (DIFF_IN / 32) + 2 * (16 * 32 + 2 * 16 * (DFF / 32) + (DFF / 64) * 32);
        for (int it = gw; it < NITEMS; it += NGW) {
            int r = it;
            if (transpose_mat(r, a.par_w_in, DMODEL, PAR_IN, W_IN(0), 0, scr, lane)) continue;
            if (transpose_mat(r, a.par_w_out, DMODEL, DMODEL, W_OUT(0), 0, scr, lane)) continue;
            if (transpose_mat(r, a.w_gate, DMODEL, DFF, W_GU(0), 1, scr, lane)) continue;
            if (transpose_mat(r, a.w_up, DMODEL, DFF, W_GU(0), 2, scr, lane)) continue;
            if (transpose_mat(r, a.w_down, DFF, DMODEL, W_DN(0), 0, scr, lane)) continue;
            if (transpose_mat(r, a.diff_w_in, DMODEL, DIFF_IN, W_IN(1), 0, scr, lane)) continue;
            if (transpose_mat(r, a.diff_w_out, DMODEL, DMODEL, W_OUT(1), 0, scr, lane)) continue;
            if (transpose_mat(r, a.w_gate + (size_t)DMODEL * DFF, DMODEL, DFF, W_GU(1), 1, scr, lane)) continue;
            if (transpose_mat(r, a.w_up + (size_t)DMODEL * DFF, DMODEL, DFF, W_GU(1), 2, scr, lane)) continue;
            transpose_mat(r, a.w_down + (size_t)DFF * DMODEL, DFF, DMODEL, W_DN(1), 0, scr, lane);
        }
    }
    grid.sync();
    const XcdBarrier bar = xcd_barrier_post(barw, bst);

    layer_body<0>(a, lds, bar, G, bx, vcu, gw, NGW, lane, tid, wave);
    layer_body<1>(a, lds, bar, G, bx, vcu, gw, NGW, lane, tid, wave);
    { const int lane = FRESH_LANE();
    f32x4 vn[4];
    { const int b = gw / SEQ, pos = gw - b * SEQ; const f32x4* xr = (const f32x4*)(X + ((size_t)b * TPB + CTXL + pos) * DMODEL) + lane;
#pragma unroll
        for (int j = 0; j < 4; ++j) vn[j] = xr[64 * j]; }
    for (int lr = gw; lr < NBATCH * SEQ; lr += NGW) {
        f32x4 v[4]; float ss = 0.f;
#pragma unroll
        for (int j = 0; j < 4; ++j) v[j] = vn[j];
        if (lr + NGW < NBATCH * SEQ) { const int ln = lr + NGW, b = ln / SEQ, pos = ln - b * SEQ; const f32x4* xr = (const f32x4*)(X + ((size_t)b * TPB + CTXL + pos) * DMODEL) + lane;
#pragma unroll
            for (int j = 0; j < 4; ++j) vn[j] = xr[64 * j]; }
#pragma unroll
        for (int j = 0; j < 4; ++j) ss += (v[j].x * v[j].x + v[j].y * v[j].y) + (v[j].z * v[j].z + v[j].w * v[j].w);
        const float rstd = 1.0f / sqrtf(wave_sum(ss) * (1.0f / DMODEL) + EPS);
        const f32x4* gp = (const f32x4*)a.fgain + lane; f32x4* op = (f32x4*)(a.out + (size_t)lr * DMODEL) + lane;
#pragma unroll
        for (int j = 0; j < 4; ++j) op[64 * j] = v[j] * rstd * gp[64 * j];
    } }
}

extern "C" void kernel_launch(void* const* d_in, const int* in_sizes, int n_in, void* d_out, int out_size, void* d_ws, size_t ws_size, hipStream_t stream) {
    static int grid = 0;
    if (grid == 0) {
        if (n_in != 22 || in_sizes[0] != NBATCH * SEQ * DMODEL || out_size != NBATCH * SEQ * DMODEL || ws_size < WS_MF + (size_t)8 * 15 * 2 * 64 * 16 * 4) { fprintf(stderr, "kernel_launch: unexpected problem shape (n_in %d, ws %zu)\n", n_in, ws_size); grid = -1; return; }
        int dev = 0, cus = 0, per_cu = 0;
        hipGetDevice(&dev); hipDeviceGetAttribute(&cus, hipDeviceAttributeMultiprocessorCount, dev);
        hipOccupancyMaxActiveBlocksPerMultiprocessor(&per_cu, (const void*)fwd_megakernel, NTHREADS, 0);
        if (per_cu < 1) { fprintf(stderr, "kernel_launch: occupancy query says %d blocks per CU\n", per_cu); per_cu = 1; }
        (void)hipGetLastError();
        grid = cus;
    }
    if (grid < 0) return;
    Args a{};
    const float** ap = (const float**)&a;
    for (int i = 0; i < 22; ++i) ap[i] = (const float*)d_in[i];
    a.out = (float*)d_out; a.ws = (unsigned char*)d_ws;
    void* args[] = {&a};
    hipError_t e = hipLaunchCooperativeKernel((const void*)fwd_megakernel, dim3(grid), dim3(NTHREADS), args, 0, stream);
    if (e != hipSuccess) fprintf(stderr, "cooperative launch failed: %s (grid %d)\n", hipGetErrorString(e), grid);
}
```
